# Optimizing an MI355X kernel written in HIP

```python
import jax, jax.numpy as jnp
from jax import lax
import numpy as np

D_MODEL = 1024
BATCH = 16
SEQ = 256
DEPTH = 4
DEC_BATCH = 8
DEC_SEQ = 2048
PAST_LEN = 256

GRID_W = 64
N_EVEN = (DEPTH + 1) // 2
N_ODD = DEPTH // 2
A_HEADS = 8
A_KV_HEADS = 2
A_GROUP = A_HEADS // A_KV_HEADS
HEAD_DIM = 64
WINDOW = 128
BLOCK = 128
B_HEADS = 8
Q_LORA = 192
KV_LORA = 128
QK_NOPE = 64
QK_ROPE = 32
V_DIM = 64
MLA_SCALE = (QK_NOPE + QK_ROPE) ** -0.5
A_Q_W = A_HEADS * HEAD_DIM
A_KV_W = A_KV_HEADS * HEAD_DIM
ATTN_IN_SIZES = (A_Q_W, A_KV_W, A_KV_W, Q_LORA, KV_LORA, QK_ROPE)
ATTN_IN_W = sum(ATTN_IN_SIZES)
ATTN_OUT_W = A_HEADS * HEAD_DIM + B_HEADS * V_DIM
CONV_CH = D_MODEL // 2
CONV_WIDTH = 31
POOL_CH = D_MODEL // 2
POOL_SIZES = (2, 4, 8, 16)
N_POOL_GROUPS = len(POOL_SIZES)
POOL_GROUP_W = POOL_CH // N_POOL_GROUPS
CONV_IN_SIZES = (CONV_CH, CONV_CH, POOL_CH)
CONV_IN_W = sum(CONV_IN_SIZES)
CONV_OUT_W = CONV_CH + POOL_CH
D_FF = 4 * D_MODEL
ROPE_BASE = 10000.0
EPS = 1e-6
NEG_INF = -1e30

kernel_name = "hybrid_diffusion_prefix_trunk_step"


def _split(x, sizes):
    offs = [int(v) for v in np.cumsum(sizes)[:-1]]
    return jnp.split(x, offs, axis=-1)


def rms_norm(x, g):
    xf = x.astype(jnp.float32)
    y = xf * lax.rsqrt(jnp.mean(xf * xf, axis=-1, keepdims=True) + EPS)
    return (y * g.astype(jnp.float32)).astype(x.dtype)


def layer_norm(x, g, b):
    xf = x.astype(jnp.float32)
    mu = jnp.mean(xf, axis=-1, keepdims=True)
    var = jnp.mean(jnp.square(xf - mu), axis=-1, keepdims=True)
    y = (xf - mu) * lax.rsqrt(var + EPS)
    return (y * g.astype(jnp.float32) + b.astype(jnp.float32)).astype(x.dtype)


def adaln(cond, w, b):
    m = jax.nn.silu(cond) @ w + b
    return [t[:, None, :] for t in jnp.split(m, 6, axis=-1)]


def modulate(h, shift, scale):
    return h * (1.0 + scale) + shift


def axial_rope(n, dim):
    rows = n // GRID_W
    row = jnp.repeat(jnp.arange(rows), GRID_W).astype(jnp.float32)
    col = jnp.tile(jnp.arange(GRID_W), rows).astype(jnp.float32)
    quarter = dim // 4
    inv_freq = ROPE_BASE ** (-jnp.arange(quarter, dtype=jnp.float32) / quarter)
    ang = jnp.concatenate([row[:, None] * inv_freq, col[:, None] * inv_freq], axis=-1)
    return jnp.cos(ang), jnp.sin(ang)


def apply_rope(x, cos, sin):
    half = x.shape[-1] // 2
    xf = x.astype(jnp.float32)
    x1, x2 = xf[..., :half], xf[..., half:]
    cs, sn = cos[:, None, :], sin[:, None, :]
    return jnp.concatenate([x1 * cs - x2 * sn, x1 * sn + x2 * cs], axis=-1).astype(x.dtype)


def _softmax_with_sink(s, sink):
    if sink is None:
        return jax.nn.softmax(s, axis=-1)
    col = jnp.broadcast_to(sink.astype(jnp.float32), s.shape[:-1] + (1,))
    return jax.nn.softmax(jnp.concatenate([s, col], axis=-1), axis=-1)[..., :-1]


def dense_attention(q, k, v, scale, sink=None):
    b, n, kh, g, dq = q.shape
    nb = n // BLOCK
    qb = jnp.moveaxis(q.reshape(b, nb, BLOCK, kh, g, dq), 1, 0)
    sink_b = None if sink is None else sink[None, :, :, None, None]

    def one(qi):
        s = jnp.einsum('bqhgd,bkhd->bhgqk', qi, k, preferred_element_type=jnp.float32) * scale
        p = _softmax_with_sink(s, sink_b)
        return jnp.einsum('bhgqk,bkhd->bqhgd', p.astype(v.dtype), v)

    o = lax.map(one, qb)
    return jnp.moveaxis(o, 0, 1).reshape(b, n, kh, g, v.shape[-1])


def window_attention(q, k, v, k_ctx, v_ctx, sink):
    b, n, kh, g, d = q.shape
    nb = n // BLOCK
    scale = d ** -0.5
    qb = q.reshape(b, nb, BLOCK, kh, g, d)
    pad = ((0, 0), (BLOCK, BLOCK), (0, 0), (0, 0))
    kp, vp = jnp.pad(k, pad), jnp.pad(v, pad)
    idx = (jnp.arange(nb) * BLOCK)[:, None] + jnp.arange(3 * BLOCK)[None, :]
    kb, vb = kp[:, idx], vp[:, idx]
    qpos = (jnp.arange(nb) * BLOCK)[:, None] + jnp.arange(BLOCK)[None, :]
    kpos = idx - BLOCK
    valid = ((jnp.abs(qpos[:, :, None] - kpos[:, None, :]) <= WINDOW)
             & (kpos[:, None, :] >= 0) & (kpos[:, None, :] < n))
    s_loc = jnp.einsum('bnqhgd,bnkhd->bnhgqk', qb, kb, preferred_element_type=jnp.float32) * scale
    s_loc = jnp.where(valid[None, :, None, None], s_loc, NEG_INF)
    s_ctx = jnp.einsum('bnqhgd,bkhd->bnhgqk', qb, k_ctx, preferred_element_type=jnp.float32) * scale
    n_loc = 3 * BLOCK
    p = _softmax_with_sink(jnp.concatenate([s_loc, s_ctx], axis=-1), sink[None, None, :, :, None, None])
    p_loc = p[..., :n_loc].astype(v.dtype)
    p_ctx = p[..., n_loc:].astype(v.dtype)
    o = (jnp.einsum('bnhgqk,bnkhd->bnqhgd', p_loc, vb)
         + jnp.einsum('bnhgqk,bkhd->bnqhgd', p_ctx, v_ctx))
    return o.reshape(b, n, kh, g, d)


def _attn_project(h, w_in, q_norm, kv_norm, w_qb):
    b, n, _ = h.shape
    qa, ka, va, cq, ckv, kr = _split(h @ w_in, ATTN_IN_SIZES)
    qa = qa.reshape(b, n, A_HEADS, HEAD_DIM)
    ka = ka.reshape(b, n, A_KV_HEADS, HEAD_DIM)
    va = va.reshape(b, n, A_KV_HEADS, HEAD_DIM)
    q_mla = (rms_norm(cq, q_norm) @ w_qb).reshape(b, n, B_HEADS, QK_NOPE + QK_ROPE)
    ckv = rms_norm(ckv, kv_norm)
    return qa, ka, va, q_mla, ckv, kr


def _mla_keys(ckv, kr, w_kvb):
    b, m, _ = ckv.shape
    kv = (ckv @ w_kvb).reshape(b, m, B_HEADS, QK_NOPE + V_DIM)
    k = jnp.concatenate([kv[..., :QK_NOPE],
                         jnp.broadcast_to(kr[:, :, None, :], (b, m, B_HEADS, QK_ROPE))], axis=-1)
    return k, kv[..., QK_NOPE:]


def attn_mixer_context(h, w_in, sink, q_norm, kv_norm, w_qb, w_kvb, w_out):
    b, n, _ = h.shape
    qa, ka, va, q_mla, ckv, kr = _attn_project(h, w_in, q_norm, kv_norm, w_qb)
    oa = dense_attention(qa.reshape(b, n, A_KV_HEADS, A_GROUP, HEAD_DIM), ka, va, HEAD_DIM ** -0.5,
                         sink.reshape(A_KV_HEADS, A_GROUP))
    k_m, v_m = _mla_keys(ckv, kr, w_kvb)
    ob = dense_attention(q_mla[:, :, :, None, :], k_m, v_m, MLA_SCALE)
    out = jnp.concatenate([oa.reshape(b, n, -1), ob.reshape(b, n, -1)], axis=-1) @ w_out
    return out, ka, va, ckv, kr


def attn_mixer_latent(h, ck, cv, cckv, ckr, w_in, sink, q_norm, kv_norm, w_qb, w_kvb, w_out):
    b, n, _ = h.shape
    qa, ka, va, q_mla, ckv, kr = _attn_project(h, w_in, q_norm, kv_norm, w_qb)
    cos_a, sin_a = axial_rope(n, HEAD_DIM)
    qa = apply_rope(qa, cos_a, sin_a)
    ka = apply_rope(ka, cos_a, sin_a)
    oa = window_attention(qa.reshape(b, n, A_KV_HEADS, A_GROUP, HEAD_DIM), ka, va, ck, cv,
                          sink.reshape(A_KV_HEADS, A_GROUP))
    cos_b, sin_b = axial_rope(n, QK_ROPE)
    q_mla = jnp.concatenate([q_mla[..., :QK_NOPE], apply_rope(q_mla[..., QK_NOPE:], cos_b, sin_b)], axis=-1)
    kr = apply_rope(kr[:, :, None, :], cos_b, sin_b)[:, :, 0, :]
    k_lat, v_lat = _mla_keys(ckv, kr, w_kvb)
    k_ctx, v_ctx = _mla_keys(cckv, ckr, w_kvb)
    ob = dense_attention(q_mla[:, :, :, None, :], jnp.concatenate([k_lat, k_ctx], axis=1),
                         jnp.concatenate([v_lat, v_ctx], axis=1), MLA_SCALE)
    return jnp.concatenate([oa.reshape(b, n, -1), ob.reshape(b, n, -1)], axis=-1) @ w_out


def multiscale_pool(z, w_grp, scale):
    b, n, _ = z.shape
    zf = z.astype(jnp.float32)
    cs = jnp.concatenate([jnp.zeros((b, 1, POOL_CH), jnp.float32), jnp.cumsum(zf, axis=1)], axis=1)
    t = jnp.arange(n)
    outs = []
    for gi, w in enumerate(POOL_SIZES):
        lo = w // 2
        hi = w - lo - 1
        start = jnp.clip(t - lo, 0, n)
        end = jnp.clip(t + hi + 1, 0, n)
        sl = slice(gi * POOL_GROUP_W, (gi + 1) * POOL_GROUP_W)
        csg = cs[:, :, sl]
        mean = (csg[:, end] - csg[:, start]) / (end - start).astype(jnp.float32)[None, :, None]
        outs.append(mean - zf[:, :, sl])
    d = jnp.stack(outs, axis=2).astype(z.dtype)
    y = jnp.einsum('bngc,gcd->bngd', d, w_grp).reshape(b, n, POOL_CH)
    return y * scale


def conv_pool_mixer(h, w_in, w_dw, b_dw, ln_g, ln_b, w_grp, p_scale, w_out):
    a, gate, z = _split(h @ w_in, CONV_IN_SIZES)
    u = a * jax.nn.sigmoid(gate)
    u = lax.conv_general_dilated(u, w_dw[:, None, :], window_strides=(1,),
                                 padding=[(CONV_WIDTH // 2, CONV_WIDTH // 2)],
                                 dimension_numbers=('NWC', 'WIO', 'NWC'),
                                 feature_group_count=CONV_CH) + b_dw
    u = jax.nn.silu(layer_norm(u, ln_g, ln_b))
    pz = multiscale_pool(z, w_grp, p_scale)
    return jnp.concatenate([u, pz], axis=-1) @ w_out


def sq_relu_mlp(h, w1, w2):
    return jnp.square(jax.nn.relu(h @ w1)) @ w2


def setup_inputs(seed: int = 0) -> dict:
    key = jax.random.key(seed)
    keys = iter(jax.random.split(key, 40))

    def nrm(shape, s):
        return jax.random.normal(next(keys), shape, jnp.float32) * s

    def gain(shape):
        return 1.0 + nrm(shape, 0.05)

    return {
        'x_prompt': nrm((BATCH, SEQ, D_MODEL), 1.0),
        'x_sample': nrm((DEC_BATCH, DEC_SEQ, D_MODEL), 1.0),
        'cache_win_k': nrm((DEC_BATCH, N_EVEN, PAST_LEN, A_KV_HEADS, HEAD_DIM), 1.0),
        'cache_win_v': nrm((DEC_BATCH, N_EVEN, PAST_LEN, A_KV_HEADS, HEAD_DIM), 1.0),
        'cache_mla_ckv': nrm((DEC_BATCH, N_EVEN, PAST_LEN, KV_LORA), 1.0),
        'cache_mla_krope': nrm((DEC_BATCH, N_EVEN, PAST_LEN, QK_ROPE), 1.0),
        'c': nrm((DEC_BATCH, D_MODEL), 1.0),
        'c_ctx': nrm((D_MODEL,), 1.0),
        'w_mod': nrm((DEPTH, D_MODEL, 6 * D_MODEL), 0.5 * D_MODEL ** -0.5),
        'b_mod': nrm((DEPTH, 6 * D_MODEL), 0.02),
        'norm_g': gain((DEPTH, 2, D_MODEL)),
        'attn_w_in': nrm((N_EVEN, D_MODEL, ATTN_IN_W), D_MODEL ** -0.5),
        'attn_sink': nrm((N_EVEN, A_HEADS), 0.5),
        'mla_q_norm': gain((N_EVEN, Q_LORA)),
        'mla_kv_norm': gain((N_EVEN, KV_LORA)),
        'mla_w_qb': nrm((N_EVEN, Q_LORA, B_HEADS * (QK_NOPE + QK_ROPE)), Q_LORA ** -0.5),
        'mla_w_kvb': nrm((N_EVEN, KV_LORA, B_HEADS * (QK_NOPE + V_DIM)), KV_LORA ** -0.5),
        'attn_w_out': nrm((N_EVEN, ATTN_OUT_W, D_MODEL), ATTN_OUT_W ** -0.5),
        'conv_w_in': nrm((N_ODD, D_MODEL, CONV_IN_W), D_MODEL ** -0.5),
        'conv_dw': nrm((N_ODD, CONV_WIDTH, CONV_CH), CONV_WIDTH ** -0.5),
        'conv_dw_b': nrm((N_ODD, CONV_CH), 0.02),
        'conv_ln_g': gain((N_ODD, CONV_CH)),
        'conv_ln_b': nrm((N_ODD, CONV_CH), 0.02),
        'pool_w': nrm((N_ODD, N_POOL_GROUPS, POOL_GROUP_W, POOL_GROUP_W), POOL_GROUP_W ** -0.5),
        'pool_scale': 0.5 + nrm((N_ODD, POOL_CH), 0.05),
        'conv_w_out': nrm((N_ODD, CONV_OUT_W, D_MODEL), CONV_OUT_W ** -0.5),
        'mlp_w1': nrm((DEPTH, D_MODEL, D_FF), D_MODEL ** -0.5),
        'mlp_w2': nrm((DEPTH, D_FF, D_MODEL), D_FF ** -0.5),
        'final_g': gain((D_MODEL,)),
    }


def reference(x_prompt, x_sample, cache_win_k, cache_win_v, cache_mla_ckv, cache_mla_krope, c, c_ctx,
              w_mod, b_mod, norm_g, attn_w_in, attn_sink, mla_q_norm, mla_kv_norm, mla_w_qb, mla_w_kvb,
              attn_w_out, conv_w_in, conv_dw, conv_dw_b, conv_ln_g, conv_ln_b, pool_w, pool_scale,
              conv_w_out, mlp_w1, mlp_w2, final_g):
    xp, xs = x_prompt, x_sample
    ks, vs, ckvs, krs = [], [], [], []
    for l in range(DEPTH):
        mp = adaln(c_ctx[None, :], w_mod[l], b_mod[l])
        ms = adaln(c, w_mod[l], b_mod[l])
        hp = modulate(rms_norm(xp, norm_g[l, 0]), mp[0], mp[1])
        hs = modulate(rms_norm(xs, norm_g[l, 0]), ms[0], ms[1])
        if l % 2 == 0:
            i = l // 2
            ap = (attn_w_in[i], attn_sink[i], mla_q_norm[i], mla_kv_norm[i], mla_w_qb[i], mla_w_kvb[i],
                  attn_w_out[i])
            o_p, k_i, v_i, ckv_i, kr_i = attn_mixer_context(hp, *ap)
            o_s = attn_mixer_latent(hs, cache_win_k[:, i], cache_win_v[:, i], cache_mla_ckv[:, i],
                                    cache_mla_krope[:, i], *ap)
            ks.append(k_i)
            vs.append(v_i)
            ckvs.append(ckv_i)
            krs.append(kr_i)
        else:
            j = l // 2
            cp = (conv_w_in[j], conv_dw[j], conv_dw_b[j], conv_ln_g[j], conv_ln_b[j], pool_w[j],
                  pool_scale[j], conv_w_out[j])
            o_p = conv_pool_mixer(hp, *cp)
            o_s = conv_pool_mixer(hs, *cp)
        xp = xp + mp[2] * o_p
        xs = xs + ms[2] * o_s
        hp = modulate(rms_norm(xp, norm_g[l, 1]), mp[3], mp[4])
        hs = modulate(rms_norm(xs, norm_g[l, 1]), ms[3], ms[4])
        xp = xp + mp[5] * sq_relu_mlp(hp, mlp_w1[l], mlp_w2[l])
        xs = xs + ms[5] * sq_relu_mlp(hs, mlp_w1[l], mlp_w2[l])
    y_prompt = rms_norm(xp, final_g)
    y_sample = rms_norm(xs, final_g)
    new_win_k = jnp.stack(ks, axis=1)
    new_win_v = jnp.stack(vs, axis=1)
    new_mla_ckv = jnp.stack(ckvs, axis=1)
    new_mla_krope = jnp.stack(krs, axis=1)
    return (y_prompt, y_sample, new_win_k, new_win_v, new_mla_ckv, new_mla_krope)
```

```cpp
#include <hip/hip_runtime.h>
#include <hip/hip_cooperative_groups.h>
#include <cstdio>
#include <cstdint>
namespace cg = cooperative_groups;
namespace pg8 {
#define PG8_LAS __attribute__((address_space(3)))
typedef unsigned short bf16_t;
typedef short bf16x8 __attribute__((ext_vector_type(8)));
typedef float f32x4 __attribute__((ext_vector_type(4)));
typedef unsigned u32x4 __attribute__((ext_vector_type(4)));
constexpr int BM = 256, BK = 64, HALF = 128, HTB = HALF * BK * 2  , STAGE_BYTES = 8 * HTB, NXCD = 8, WGM = 8;

__host__ __device__ __forceinline__ int lds_byte(int r, int c) { const int st = (r >> 4) * 2 + (c >> 5), rr = r & 15, cc = c & 31, ob = rr * 64 + cc * 2; return st * 1024 + (ob ^ (((ob >> 9) & 1) << 5)); }
__host__ __device__ __forceinline__ void stage_rc(int b, int& R, int& C) { const int st = b / 1024, sb = b % 1024, swz = sb ^ (((sb >> 9) & 1) << 5); R = (st >> 1) * 16 + swz / 64; C = (st & 1) * 32 + (swz % 64) / 2; }
__host__ __device__ __forceinline__ int perm32(int rho) { const int n = rho >> 4, i = rho & 15; return 8 * (i >> 2) + 4 * n + (i & 3); }

struct Unit { int pm, pn, k0, nt; };
struct Gemm { const bf16_t* A; const bf16_t* Bt; int M, N, K; };

struct StaticOrder {
    int nM, nN, nwg, G, c, ntk;
    __host__ __device__ __forceinline__ void init(int M, int N, int K, int G_, int c_) { nM = M / BM; nN = N / BM; nwg = nM * nN; G = G_; c = c_; ntk = K / BK; }
    __host__ __device__ __forceinline__ bool next(int i, Unit& u) const {
        const long L = (long)i * G + c; if (L >= nwg) return false;
        int wgid = (int)L; { const int q = nwg / NXCD, r = nwg % NXCD, xcd = wgid % NXCD, off = wgid / NXCD; wgid = (xcd < r ? xcd * (q + 1) : r * (q + 1) + (xcd - r) * q) + off; }
        const int nig = WGM * nN, gid = wgid / nig, fm = gid * WGM, gsz = (nM - fm) < WGM ? (nM - fm) : WGM;
        u.pm = fm + ((wgid % nig) % gsz); u.pn = (wgid % nig) / gsz; u.k0 = 0; u.nt = ntk; return true;
    }
    __device__ __forceinline__ void a_ready(const Unit&) const {}
    __device__ __forceinline__ void done(const Unit&) const {}
};

struct SplitKOrder {
    int nN, C, ntc, q0, q1;
    __host__ __device__ __forceinline__ void init(int M, int N, int K, int C_, int G_, int c_) { nN = N / BM; C = C_; ntc = K / BK / C_; const int nq = (M / BM) * nN * C_;
        const int cl = (G_ % NXCD == 0) ? (c_ % NXCD) * (G_ / NXCD) + c_ / NXCD : c_; const int per = (nq + G_ - 1) / G_; q0 = cl * per; q1 = q0 + per < nq ? q0 + per : nq; }
    __host__ __device__ __forceinline__ bool next(int i, Unit& u) const {
        int q = q0;
        for (int k = 0; k <= i; ++k) { if (q >= q1) return false; const int tile = q / C, kq = q % C; const int cnt = (C - kq) < (q1 - q) ? (C - kq) : (q1 - q);
            if (k == i) { u.pm = tile / nN; u.pn = tile % nN; u.k0 = kq * ntc * BK; u.nt = cnt * ntc; return true; } q += cnt; }
        return false;
    }
    __device__ __forceinline__ void a_ready(const Unit&) const {}
    __device__ __forceinline__ void done(const Unit&) const {}
};

struct StaticOrder4 : StaticOrder { static constexpr int kSplit = 0; __host__ __device__ __forceinline__ void init(int M, int N, int K, int, int G_, int c_) { StaticOrder::init(M, N, K, G_, c_); } };
struct RoundSplitOrder {
    static constexpr int kSplit = 1;
    int nN, C, ntk, cl, G;
    __host__ __device__ __forceinline__ void init(int M, int N, int K, int C_, int G_, int c_) { nN = N / BM; C = C_; ntk = K / BK; G = G_; (void)M;
        cl = (G_ % NXCD == 0) ? (c_ % NXCD) * (G_ / NXCD) + c_ / NXCD : c_; }
    __host__ __device__ __forceinline__ bool next(int i, Unit& u) const {
        if (i > 1) return false;
        int tile;
        const int part = cl % C; const bool split_now = ((cl / C) & 1) ? (i == 0) : (i == 1);
        if (!split_now) { tile = cl; u.k0 = 0; u.nt = ntk; } else { tile = G + cl / C; u.nt = ntk / C; u.k0 = part * u.nt * BK; }
        u.pm = tile / nN; u.pn = tile % nN; return true;
    }
    __device__ __forceinline__ void a_ready(const Unit&) const {}
    __device__ __forceinline__ void done(const Unit&) const {}
};

__device__ __forceinline__ unsigned cvt_pk_bf16(float lo, float hi) { unsigned r; asm volatile("v_cvt_pk_bf16_f32 %0, %1, %2" : "=v"(r) : "v"(lo), "v"(hi)); return r; }

typedef unsigned u32x2 __attribute__((ext_vector_type(2)));
__device__ __forceinline__ int epi_cond(int pm) { return pm < 16 ? 0 : 1 + ((pm - 16) >> 3); }
__device__ __forceinline__ float epi_rstd(const float* rowsq, int row) { return __builtin_amdgcn_rsqf(rowsq[row] * (1.0f / 1024.0f) + 1e-6f); }
template <int ACT, bool NORM> struct EpiStore {
    static constexpr bool PERM = true, AFTER_DRAIN = false;
    bf16_t* O; int ldc; const float* rowsq; const float* bias;
    __device__ __forceinline__ void operator()(const f32x4 (&acc)[2][2][4][2], const Unit& u, int wr, int wc, int fr, int fq) const {
        const int row0 = u.pm * BM + wr * 64 + fr; const int col0 = u.pn * BM + wc * 32 + 8 * fq;
        float rs[2][4];
        if (NORM) {
#pragma unroll
            for (int ai = 0; ai < 2; ++ai)
#pragma unroll
                for (int m = 0; m < 4; ++m) rs[ai][m] = epi_rstd(rowsq, row0 + ai * HALF + m * 16); }
        const float* bp = NORM ? bias + (size_t)epi_cond(u.pm) * 4096 + col0 : nullptr;
        f32x4 bb[2][2];
#pragma unroll
        for (int bj = 0; bj < 2; ++bj) { bb[bj][0] = (f32x4){0.f, 0.f, 0.f, 0.f}; bb[bj][1] = bb[bj][0];
            if (NORM) { bb[bj][0] = *(const f32x4*)(bp + bj * HALF); bb[bj][1] = *(const f32x4*)(bp + bj * HALF + 4); } }
#pragma unroll
        for (int bj = 0; bj < 2; ++bj) {
            const f32x4 b0 = bb[bj][0], b1 = bb[bj][1];
#pragma unroll
            for (int ai = 0; ai < 2; ++ai)
#pragma unroll
                for (int m = 0; m < 4; ++m) { bf16_t* rowp = O + (size_t)(row0 + ai * HALF + m * 16) * ldc + col0;
                    f32x4 v0 = acc[ai][bj][m][0], v1 = acc[ai][bj][m][1];
                    if (NORM) { v0 = v0 * rs[ai][m] + b0; v1 = v1 * rs[ai][m] + b1; }
                    if (ACT == 1) {
#pragma unroll
                        for (int j = 0; j < 4; ++j) { const float a = fmaxf(v0[j], 0.f), b = fmaxf(v1[j], 0.f); v0[j] = a * a; v1[j] = b * b; } }
                    u32x4 w; w.x = cvt_pk_bf16(v0[0], v0[1]); w.y = cvt_pk_bf16(v0[2], v0[3]); w.z = cvt_pk_bf16(v1[0], v1[1]); w.w = cvt_pk_bf16(v1[2], v1[3]);
                    *(u32x4*)(rowp + bj * HALF) = w; }
        }
    }
};
struct EpiGlu {
    static constexpr bool PERM = true, AFTER_DRAIN = false;
    bf16_t* U; bf16_t* ZW; const float* rowsq; const float* bias;
    __device__ __forceinline__ void operator()(const f32x4 (&acc)[2][2][4][2], const Unit& u, int wr, int wc, int fr, int fq) const {
        const int row0 = u.pm * BM + wr * 64 + fr;
        const float* bp = bias + (size_t)epi_cond(u.pm) * 4096 + u.pn * BM + wc * 32 + 8 * fq;
        const f32x4 ba0 = *(const f32x4*)bp, ba1 = *(const f32x4*)(bp + 4), bg0 = *(const f32x4*)(bp + HALF), bg1 = *(const f32x4*)(bp + HALF + 4);
        float rsv[2][4];
#pragma unroll
        for (int ai = 0; ai < 2; ++ai)
#pragma unroll
            for (int m = 0; m < 4; ++m) rsv[ai][m] = epi_rstd(rowsq, row0 + ai * HALF + m * 16);
        if (u.pn < 4) {
            const int col0 = u.pn * 128 + wc * 32 + 8 * fq;
#pragma unroll
            for (int ai = 0; ai < 2; ++ai)
#pragma unroll
                for (int m = 0; m < 4; ++m) { const int row = row0 + ai * HALF + m * 16; bf16_t* rowp = U + (size_t)row * 512 + col0; const float rs = rsv[ai][m];
                    const f32x4 a0 = acc[ai][0][m][0] * rs + ba0, a1 = acc[ai][0][m][1] * rs + ba1, g0 = acc[ai][1][m][0] * rs + bg0, g1 = acc[ai][1][m][1] * rs + bg1;
                    f32x4 v0, v1;
#pragma unroll
                    for (int j = 0; j < 4; ++j) {
                        v0[j] = a0[j] * __builtin_amdgcn_rcpf(1.0f + __expf(-g0[j]));
                        v1[j] = a1[j] * __builtin_amdgcn_rcpf(1.0f + __expf(-g1[j])); }
                    u32x4 w; w.x = cvt_pk_bf16(v0[0], v0[1]); w.y = cvt_pk_bf16(v0[2], v0[3]); w.z = cvt_pk_bf16(v1[0], v1[1]); w.w = cvt_pk_bf16(v1[2], v1[3]);
                    *(u32x4*)rowp = w; }
        } else {
            const int col0 = (u.pn - 4) * BM + wc * 32 + 8 * fq;
#pragma unroll
            for (int ai = 0; ai < 2; ++ai)
#pragma unroll
                for (int m = 0; m < 4; ++m) { const int row = row0 + ai * HALF + m * 16; bf16_t* rowp = ZW + (size_t)row * 512 + col0; const float rs = rsv[ai][m];
#pragma unroll
                    for (int bj = 0; bj < 2; ++bj) { const f32x4 v0 = acc[ai][bj][m][0] * rs + (bj ? bg0 : ba0), v1 = acc[ai][bj][m][1] * rs + (bj ? bg1 : ba1);
                        u32x4 w; w.x = cvt_pk_bf16(v0[0], v0[1]); w.y = cvt_pk_bf16(v0[2], v0[3]); w.z = cvt_pk_bf16(v1[0], v1[1]); w.w = cvt_pk_bf16(v1[2], v1[3]);
                        *(u32x4*)(rowp + bj * HALF) = w; } }
        }
    }
};
struct EpiResid {
    static constexpr bool PERM = false, AFTER_DRAIN = false;
    float* X; const float* gate_l;
    bf16_t* An; const float* gn; const float* scn_l; float* rowsq_n;
    float gscale;
    float* Pex; unsigned* cnt; unsigned target; int full_nt;
    __device__ __forceinline__ void operator()(f32x4 (&acc)[2][2][4][2], const Unit& u, int wr, int wc, int fr, int fq) const {
        typedef __attribute__((address_space(1))) f32x4 gf32x4; typedef __attribute__((address_space(1))) float gfloat;
        int sai = -1, sbj = -1;
        if (u.nt != full_nt) {
            const int st = (u.pm * 4 + u.pn) - 256, part = u.k0 / (u.nt * BK); const int tid = (wr * 4 + wc) * 64 + fq * 16 + fr;
            sai = part >> 1; sbj = part & 1;
            const __amdgpu_buffer_rsrc_t rs = __builtin_amdgcn_make_buffer_rsrc(Pex, 0, 64 * 4 * 4 * 8 * 512 * 16, 0x00020000);
#pragma unroll
            for (int ai = 0; ai < 2; ++ai)
#pragma unroll
                for (int bj = 0; bj < 2; ++bj) { if (ai == sai && bj == sbj) continue;
                    const unsigned off0 = (unsigned)(((((st * 4 + part) * 4 + ai * 2 + bj) * 8) * 512 + tid) * 16);
#pragma unroll
                    for (int m = 0; m < 4; ++m)
#pragma unroll
                        for (int n = 0; n < 2; ++n) __builtin_amdgcn_raw_buffer_store_b128(__builtin_bit_cast(u32x4, acc[ai][bj][m][n]), rs, off0 + (unsigned)((m * 2 + n) * 512 * 16), 0, 16); }
            asm volatile("s_waitcnt vmcnt(0)" ::: "memory"); __builtin_amdgcn_s_barrier(); asm volatile("" ::: "memory");
            if (tid == 0) { (void)__hip_atomic_fetch_add(cnt + 64 * st, 1u, __ATOMIC_RELAXED, __HIP_MEMORY_SCOPE_AGENT); unsigned sp = 0;
                while (__hip_atomic_load(cnt + 64 * st, __ATOMIC_RELAXED, __HIP_MEMORY_SCOPE_AGENT) < target) { __builtin_amdgcn_s_sleep(2); if (++sp > (1u << 22)) break; }
                __builtin_amdgcn_fence(__ATOMIC_ACQUIRE, "agent"); asm volatile("s_waitcnt vmcnt(0)" ::: "memory"); }
            asm volatile("s_waitcnt vmcnt(0) lgkmcnt(0)" ::: "memory"); __builtin_amdgcn_s_barrier(); asm volatile("" ::: "memory");
#pragma unroll
            for (int ai = 0; ai < 2; ++ai)
#pragma unroll
                for (int bj = 0; bj < 2; ++bj) { if (ai != sai || bj != sbj) continue;
#pragma unroll
                    for (int w = 1; w < 4; ++w) { const int wp = (part + w) & 3;
                        const gf32x4* p = (const gf32x4*)Pex + ((size_t)(((st * 4 + wp) * 4 + ai * 2 + bj) * 8)) * 512 + tid;
#pragma unroll
                        for (int m = 0; m < 4; ++m)
#pragma unroll
                            for (int n = 0; n < 2; ++n) acc[ai][bj][m][n] += p[(size_t)(m * 2 + n) * 512]; } }
        }
        const int cond = epi_cond(u.pm);
        const float* gate = gate_l + (size_t)cond * 6144; const float* scn = scn_l + (size_t)cond * 6144;
        const int col0 = u.pn * BM + wc * 32 + 4 * fq; const int rowt = u.pm * BM + wr * 64 + fr;
        float ssq[2][4];
#pragma unroll
        for (int ai = 0; ai < 2; ++ai)
#pragma unroll
            for (int m = 0; m < 4; ++m) ssq[ai][m] = 0.f;
        f32x4 xs[2][4], gvv[2], gmm[2];
#define ER_ACT(b_) (sbj < 0 || ((((b_) >> 2) == sbj) && (((b_) & 1) == sai)))
#define ER_LOAD(b_, q_) do { const int c_ = col0 + ((b_) >> 2) * HALF + (((b_) >> 1) & 1) * 16; \
        _Pragma("unroll") for (int m = 0; m < 4; ++m) xs[q_][m] = *(const gf32x4*)(X + (size_t)(rowt + ((b_) & 1) * HALF + m * 16) * 1024 + c_); \
        gvv[q_] = *(const f32x4*)(gate + c_) * gscale; gmm[q_] = An ? *(const f32x4*)(gn + c_) * (*(const f32x4*)(scn + c_) + 1.0f) : (f32x4){0.f, 0.f, 0.f, 0.f}; } while (0)
        if (ER_ACT(0)) ER_LOAD(0, 0);
#pragma unroll
        for (int b = 0; b < 8; ++b) {
            const int bj = b >> 2, n = (b >> 1) & 1, ai = b & 1, q = b & 1, c = col0 + bj * HALF + n * 16;
            if (b + 1 < 8) { if (ER_ACT(b + 1)) ER_LOAD(b + 1, q ^ 1); }
            if (!ER_ACT(b)) continue;
#pragma unroll
            for (int m = 0; m < 4; ++m) { const size_t off = (size_t)(rowt + ai * HALF + m * 16) * 1024 + c;
                const f32x4 x = xs[q][m] + gvv[q] * acc[ai][bj][m][n]; *(gf32x4*)(X + off) = x;
                if (An) { ssq[ai][m] += (x[0] * x[0] + x[1] * x[1]) + (x[2] * x[2] + x[3] * x[3]); const f32x4 h = x * gmm[q];
                    u32x2 w; w.x = cvt_pk_bf16(h[0], h[1]); w.y = cvt_pk_bf16(h[2], h[3]); *(u32x2*)(An + off) = w; } }
        }
#undef ER_ACT
#undef ER_LOAD
        if (An) {
            const int lane = fq * 16 + fr;
#pragma unroll
            for (int ai = 0; ai < 2; ++ai)
#pragma unroll
                for (int m = 0; m < 4; ++m) { if (sai >= 0 && ai != sai) continue; float s = ssq[ai][m];
                    s += __builtin_bit_cast(float, __builtin_amdgcn_ds_bpermute((lane ^ 16) << 2, __builtin_bit_cast(int, s)));
                    s += __builtin_bit_cast(float, __builtin_amdgcn_ds_bpermute((lane ^ 32) << 2, __builtin_bit_cast(int, s)));
                    if (fq == 0) (void)__hip_atomic_fetch_add((gfloat*)(rowsq_n + rowt + ai * HALF + m * 16), s, __ATOMIC_RELAXED, __HIP_MEMORY_SCOPE_AGENT); }
        }
    }
};
struct EpiQm {
    static constexpr bool PERM = false, AFTER_DRAIN = false;
    bf16_t* Qm; float qscale;
    __device__ __forceinline__ void operator()(const f32x4 (&acc)[2][2][4][2], const Unit& u, int wr, int wc, int fr, int fq) const {
        float invf[4];
#pragma unroll
        for (int j = 0; j < 4; ++j) invf[j] = exp2f(-(float)(4 * (fq & 1) + j) * (13.287712379549449f / 8.0f)) * 0.15915494309189535f;
#pragma unroll
        for (int bj = 0; bj < 2; ++bj) {
            const int cgp = u.pn * BM + bj * HALF + wc * 32;
            const bool is_rope = ((cgp >> 5) % 3) == 2;
#pragma unroll
            for (int ai = 0; ai < 2; ++ai)
#pragma unroll
                for (int m = 0; m < 4; ++m) {
                    const int r = u.pm * BM + ai * HALF + wr * 64 + m * 16 + fr;
                    f32x4 v0 = acc[ai][bj][m][0], v1 = acc[ai][bj][m][1];
                    if (is_rope && r >= 4096) {
                        const int t = (r - 4096) & 2047; const float pos = (float)((fq < 2) ? (t >> 6) : (t & 63));
#pragma unroll
                        for (int j = 0; j < 4; ++j) { const float rev = pos * invf[j]; const float c = __builtin_amdgcn_cosf(rev), s = __builtin_amdgcn_sinf(rev);
                            const float x1 = v0[j], x2 = v1[j]; v0[j] = x1 * c - x2 * s; v1[j] = x1 * s + x2 * c; }
                    }
                    v0 = v0 * qscale; v1 = v1 * qscale;
                    bf16_t* p = Qm + (size_t)r * 768 + cgp + 4 * fq;
                    u32x2 w0, w1; w0.x = cvt_pk_bf16(v0[0], v0[1]); w0.y = cvt_pk_bf16(v0[2], v0[3]); w1.x = cvt_pk_bf16(v1[0], v1[1]); w1.y = cvt_pk_bf16(v1[2], v1[3]);
                    *(u32x2*)p = w0; *(u32x2*)(p + 16) = w1;
                }
        }
    }
};

template <class Epi, class Sched, bool ALIGN_EPI = false, bool SP2 = false>
__device__ __forceinline__ void gemm_phase(PG8_LAS unsigned char* lds, const Gemm g, const Sched& S, const Epi& E, const int tid_in) {
    const int tid = tid_in, wid = __builtin_amdgcn_readfirstlane(tid >> 6), lane = tid & 63, wr = wid >> 2, wc = wid & 3, fr = lane & 15, fq = lane >> 4;
    const int K = g.K;
    unsigned voffA[2], voffB[2];
#pragma unroll
    for (int i = 0; i < 2; ++i) { int R, C; stage_rc(tid * 16 + i * 8192, R, C); const int Rb = Epi::PERM ? ((R & ~31) + perm32(R & 31)) : R;
        voffA[i] = (unsigned)(R * K + C) * 2u; voffB[i] = (unsigned)(Rb * K + C) * 2u; }
    const size_t kstep = (size_t)(BK * 2);
    const size_t hstep = (size_t)HALF * K * 2;
    const size_t tstep = 2 * hstep;
    const unsigned ldsw = (unsigned)wid * 1024u;
    const int aoff = lds_byte(wr * 64 + fr, fq * 8), boff = lds_byte(wc * 32 + fr, fq * 8);
#define PG8_SA(b, h) (((b) * 2 + (h)) * HTB)
#define PG8_SB(b, h) ((4 + (b) * 2 + (h)) * HTB)
#define PG8_STAGE(bufoff, gbase, voff) do { _Pragma("unroll") for (int _i = 0; _i < 2; ++_i) \
        __builtin_amdgcn_global_load_lds((const unsigned*)((const char*)(gbase) + (voff)[_i]), (PG8_LAS unsigned*)(lds + (bufoff) + ldsw + _i * 8192), 16, 0, 0); } while (0)
#define PG8_LDA(dst, b, h) do { _Pragma("unroll") for (int m = 0; m < 4; ++m) _Pragma("unroll") for (int k = 0; k < 2; ++k) dst[m][k] = *(const PG8_LAS bf16x8*)(lds + PG8_SA(b, h) + aoff + m * 2048 + k * 1024); } while (0)
#define PG8_LDB(dst, b, h) do { _Pragma("unroll") for (int n = 0; n < 2; ++n) _Pragma("unroll") for (int k = 0; k < 2; ++k) dst[n][k] = *(const PG8_LAS bf16x8*)(lds + PG8_SB(b, h) + boff + n * 2048 + k * 1024); } while (0)
#define PG8_MMA(ai, bj, At, Bt) do { __builtin_amdgcn_s_setprio(1); _Pragma("unroll") for (int m = 0; m < 4; ++m) _Pragma("unroll") for (int n = 0; n < 2; ++n) _Pragma("unroll") for (int k = 0; k < 2; ++k) \
        acc[ai][bj][m][n] = __builtin_amdgcn_mfma_f32_16x16x32_bf16(Bt[n][k], At[m][k], acc[ai][bj][m][n], 0, 0, 0); __builtin_amdgcn_s_setprio(0); } while (0)
#define PG8_WAIT_V(n) asm volatile("s_waitcnt vmcnt(" #n ")" ::: "memory")
#define PG8_WAIT_L(n) asm volatile("s_waitcnt lgkmcnt(" #n ")" ::: "memory")
#define PG8_BAR __builtin_amdgcn_s_barrier()
#define PG8_SCHED __builtin_amdgcn_sched_barrier(0)
    Unit cur, nxt; int ui = 0;
    if (!S.next(0, cur)) return;
    f32x4 acc[2][2][4][2];
#pragma unroll
    for (int a = 0; a < 2; ++a)
#pragma unroll
        for (int b = 0; b < 2; ++b)
#pragma unroll
            for (int m = 0; m < 4; ++m)
#pragma unroll
                for (int n = 0; n < 2; ++n) acc[a][b][m][n] = (f32x4){0.f, 0.f, 0.f, 0.f};
    bf16x8 At[4][2], B0[2][2], B1[2][2];
    const char* cA = (const char*)g.A + (size_t)cur.pm * tstep + (size_t)cur.k0 * 2; const char* cB = (const char*)g.Bt + (size_t)cur.pn * tstep + (size_t)cur.k0 * 2;
    S.a_ready(cur);
    if constexpr (SP2) {
        PG8_STAGE(PG8_SB(0, 0), cB, voffB); PG8_STAGE(PG8_SB(0, 1), cB + hstep, voffB); PG8_STAGE(PG8_SA(0, 0), cA, voffA); PG8_STAGE(PG8_SA(0, 1), cA + hstep, voffA);
        if (wr == 1) PG8_BAR;
        PG8_WAIT_V(2); PG8_BAR;
        PG8_STAGE(PG8_SB(1, 0), cB + kstep, voffB); PG8_STAGE(PG8_SA(1, 0), cA + kstep, voffA); PG8_STAGE(PG8_SB(1, 1), cB + hstep + kstep, voffB);
        PG8_WAIT_V(6); PG8_BAR;
    } else {
        PG8_STAGE(PG8_SB(0, 0), cB, voffB); PG8_STAGE(PG8_SA(0, 0), cA, voffA); PG8_STAGE(PG8_SB(0, 1), cB + hstep, voffB); PG8_STAGE(PG8_SA(0, 1), cA + hstep, voffA);
        if (wr == 1) PG8_BAR;
        PG8_WAIT_V(4); PG8_BAR;
        PG8_STAGE(PG8_SB(1, 0), cB + kstep, voffB); PG8_STAGE(PG8_SA(1, 0), cA + kstep, voffA); PG8_STAGE(PG8_SB(1, 1), cB + hstep + kstep, voffB);
        PG8_WAIT_V(6); PG8_BAR;
    }
    for (;;) {
        const bool has_next = S.next(ui + 1, nxt);
        const char* nA = has_next ? (const char*)g.A + (size_t)nxt.pm * tstep + (size_t)nxt.k0 * 2 : cA; const char* nB = has_next ? (const char*)g.Bt + (size_t)nxt.pn * tstep + (size_t)nxt.k0 * 2 : cB;
        const int nt = cur.nt;
        for (int t = 0; t < nt; t += 2) {
            const bool last = (t == nt - 2);
            const char* a1 = cA + (size_t)(t + 1) * kstep;
            const char* a2 = last ? nA : cA + (size_t)(t + 2) * kstep; const char* b2 = last ? nB : cB + (size_t)(t + 2) * kstep;
            const char* a3 = a2 + kstep; const char* b3 = b2 + kstep;
            if (last && has_next) S.a_ready(nxt);
            if constexpr (SP2) {
            PG8_LDB(B0, 0, 0); PG8_LDB(B1, 0, 1); PG8_SCHED; PG8_LDA(At, 0, 0); PG8_STAGE(PG8_SA(1, 1), a1 + hstep, voffA);
            PG8_WAIT_V(8); PG8_WAIT_L(0); PG8_BAR; PG8_MMA(0, 0, At, B0); PG8_MMA(0, 1, At, B1); PG8_BAR; PG8_SCHED;
            PG8_LDA(At, 0, 1); PG8_STAGE(PG8_SB(0, 0), b2, voffB); PG8_STAGE(PG8_SB(0, 1), b2 + hstep, voffB); PG8_STAGE(PG8_SA(0, 0), a2, voffA);
            PG8_WAIT_V(8); PG8_WAIT_L(0); PG8_BAR; PG8_MMA(1, 0, At, B0); PG8_MMA(1, 1, At, B1); PG8_BAR; PG8_SCHED;
            PG8_LDB(B0, 1, 0); PG8_LDB(B1, 1, 1); PG8_SCHED; PG8_LDA(At, 1, 0); PG8_STAGE(PG8_SA(0, 1), a2 + hstep, voffA);
            PG8_WAIT_V(8); PG8_WAIT_L(0); PG8_BAR; PG8_MMA(0, 0, At, B0); PG8_MMA(0, 1, At, B1); PG8_BAR; PG8_SCHED;
            PG8_LDA(At, 1, 1); PG8_STAGE(PG8_SB(1, 0), b3, voffB); PG8_STAGE(PG8_SB(1, 1), b3 + hstep, voffB); PG8_STAGE(PG8_SA(1, 0), a3, voffA);
            PG8_WAIT_V(8); PG8_WAIT_L(0); PG8_BAR; PG8_MMA(1, 0, At, B0); PG8_MMA(1, 1, At, B1); PG8_BAR; PG8_SCHED;
            } else {
            PG8_LDB(B0, 0, 0); PG8_SCHED; PG8_LDA(At, 0, 0); PG8_STAGE(PG8_SA(1, 1), a1 + hstep, voffA);
            PG8_WAIT_L(8); PG8_BAR; PG8_WAIT_L(0); PG8_MMA(0, 0, At, B0); PG8_BAR; PG8_SCHED;
            PG8_LDB(B1, 0, 1); PG8_STAGE(PG8_SB(0, 0), b2, voffB);
            PG8_BAR; PG8_WAIT_L(0); PG8_MMA(0, 1, At, B1); PG8_BAR;
            PG8_LDA(At, 0, 1); PG8_STAGE(PG8_SA(0, 0), a2, voffA);
            PG8_BAR; PG8_WAIT_L(0); PG8_MMA(1, 0, At, B0); PG8_BAR; PG8_SCHED;
            PG8_STAGE(PG8_SB(0, 1), b2 + hstep, voffB);
            PG8_WAIT_V(6); PG8_BAR; PG8_MMA(1, 1, At, B1); PG8_BAR;
            PG8_LDB(B0, 1, 0); PG8_SCHED; PG8_LDA(At, 1, 0); PG8_STAGE(PG8_SA(0, 1), a2 + hstep, voffA);
            PG8_WAIT_L(8); PG8_BAR; PG8_WAIT_L(0); PG8_MMA(0, 0, At, B0); PG8_BAR; PG8_SCHED;
            PG8_LDB(B1, 1, 1); PG8_STAGE(PG8_SB(1, 0), b3, voffB);
            PG8_BAR; PG8_WAIT_L(0); PG8_MMA(0, 1, At, B1); PG8_BAR;
            PG8_LDA(At, 1, 1); PG8_STAGE(PG8_SA(1, 0), a3, voffA);
            PG8_BAR; PG8_WAIT_L(0); PG8_MMA(1, 0, At, B0); PG8_BAR; PG8_SCHED;
            PG8_STAGE(PG8_SB(1, 1), b3 + hstep, voffB);
            PG8_WAIT_V(6); PG8_BAR; PG8_MMA(1, 1, At, B1); PG8_BAR;
            }
        }
        if constexpr (ALIGN_EPI) { if (wr == 0) PG8_BAR; }
        if constexpr (!Epi::AFTER_DRAIN) { E(acc, cur, wr, wc, fr, fq); S.done(cur); }
        if (!has_next) break;
#pragma unroll
        for (int a = 0; a < 2; ++a)
#pragma unroll
            for (int b = 0; b < 2; ++b)
#pragma unroll
                for (int m = 0; m < 4; ++m)
#pragma unroll
                    for (int n = 0; n < 2; ++n) acc[a][b][m][n] = (f32x4){0.f, 0.f, 0.f, 0.f};
        cur = nxt; cA = nA; cB = nB; ++ui;
        if constexpr (ALIGN_EPI) { if (wr == 1) PG8_BAR; }
    }
    PG8_WAIT_V(0);
    if constexpr (!ALIGN_EPI) { if (wr == 0) PG8_BAR; }
    PG8_BAR;
    if constexpr (Epi::AFTER_DRAIN) { E.fused(acc, cur, wr, wc, fr, fq, lds, wid, lane); S.done(cur); }
#undef PG8_SA
#undef PG8_SB
#undef PG8_STAGE
#undef PG8_LDA
#undef PG8_LDB
#undef PG8_MMA
#undef PG8_WAIT_V
#undef PG8_WAIT_L
#undef PG8_BAR
#undef PG8_SCHED
}
}

#define LAS __attribute__((address_space(3)))
#define GAS __attribute__((address_space(1)))
typedef unsigned short bf16;
typedef float f32x4 __attribute__((ext_vector_type(4)));
typedef float f32x16 __attribute__((ext_vector_type(16)));
typedef short bf16x8 __attribute__((ext_vector_type(8)));
typedef short s16x4 __attribute__((ext_vector_type(4)));
typedef unsigned u32x4 __attribute__((ext_vector_type(4)));
typedef unsigned u32x2 __attribute__((ext_vector_type(2)));

constexpr int NWAVES = 8, NTHREADS = 512;
constexpr int DM = 1024, NCTX = 4096, NLAT = 16384, T = NCTX + NLAT, TR = T + 2048;
constexpr int DEPTH = 4, FF = 4096;
constexpr int AIN = 1120, AINP = 1280;
constexpr float EPS = 1e-6f;
constexpr float LOG2E = 1.4426950408889634f;
constexpr float QS_A = 0.125f * LOG2E;
constexpr float QS_M = 0.10206207261596575f * LOG2E;
constexpr float NEGBIG = -1.0e30f;

constexpr size_t OUT_Y = 0, OUT_K = (size_t)T * DM, OUT_V = OUT_K + 1048576, OUT_CKV = OUT_V + 1048576, OUT_KR = OUT_CKV + 1048576, OUT_END = OUT_KR + 262144;

constexpr size_t MiB = 1u << 20;
constexpr size_t WS_MOD = 1 * MiB;
constexpr size_t WS_WIN = 2 * MiB;
constexpr size_t WS_WQB = 7 * MiB;
constexpr size_t WS_WKVB = 8 * MiB;
constexpr size_t WS_WOUT = 9 * MiB;
constexpr size_t WS_CIN = 13 * MiB;
constexpr size_t WS_COUT = 19 * MiB;
constexpr size_t WS_W1 = 23 * MiB;
constexpr size_t WS_W2 = 55 * MiB;
constexpr size_t WS_ROWSQ = 64 * 1024;
constexpr size_t WS_X = 88 * MiB;
constexpr size_t WS_S = 168 * MiB;
constexpr size_t WS_QA = WS_S + 0 * MiB;
constexpr size_t WS_KA = WS_S + 20 * MiB;
constexpr size_t WS_VA = WS_S + 26 * MiB;
constexpr size_t WS_KRR = WS_S + 32 * MiB;
constexpr size_t WS_PROJ = WS_S + 34 * MiB;
constexpr size_t WS_QM = WS_S + 34 * MiB;
constexpr size_t WS_KV = WS_S + 64 * MiB;
constexpr size_t WS_O = WS_S + 110 * MiB;
constexpr size_t WS_CQN = WS_S + 150 * MiB;
constexpr size_t WS_CKVN = WS_S + 144 * MiB;
constexpr size_t WS_HID = WS_S;
constexpr size_t WS_H = 328 * MiB;
constexpr size_t WS_BIAS = 368 * MiB;
constexpr size_t WS_END = 370 * MiB;

constexpr int LDS_BYTES = 147456;

struct Args {
    const float* x_prompt; const float* x_sample; const float* cache_win_k; const float* cache_win_v; const float* cache_mla_ckv; const float* cache_mla_krope;
    const float* c; const float* c_ctx; const float* w_mod; const float* b_mod; const float* norm_g; const float* attn_w_in; const float* attn_sink;
    const float* mla_q_norm; const float* mla_kv_norm; const float* mla_w_qb; const float* mla_w_kvb; const float* attn_w_out; const float* conv_w_in;
    const float* conv_dw; const float* conv_dw_b; const float* conv_ln_g; const float* conv_ln_b; const float* pool_w; const float* pool_scale;
    const float* conv_w_out; const float* mlp_w1; const float* mlp_w2; const float* final_g;
    float* out; unsigned char* ws;
    int ph_lo, ph_hi;
};

__device__ __forceinline__ unsigned f2bf(float f) { unsigned u = __builtin_bit_cast(unsigned, f); return (u + 0x7fffu + ((u >> 16) & 1u)) >> 16; }
__device__ __forceinline__ unsigned pk2(float lo, float hi) { return f2bf(lo) | (f2bf(hi) << 16); }
__device__ __forceinline__ float bf2f(unsigned short b) { return __builtin_bit_cast(float, (unsigned)b << 16); }
__device__ __forceinline__ float shfl_xor_l(float v, int lane, int o) { return __builtin_bit_cast(float, __builtin_amdgcn_ds_bpermute((lane ^ o) << 2, __builtin_bit_cast(int, v))); }
template <int CTRL> __device__ __forceinline__ float dpp_get(float v) { return __builtin_bit_cast(float, __builtin_amdgcn_update_dpp(0, __builtin_bit_cast(int, v), CTRL, 0xF, 0xF, false)); }
__device__ __forceinline__ float wave_sum(float v, int lane) {
    (void)lane;
    v += dpp_get<0xB1>(v);
    v += dpp_get<0x4E>(v);
    v += dpp_get<0x141>(v);
    v += dpp_get<0x140>(v);
    const int b = __builtin_bit_cast(int, v);
    return (__builtin_bit_cast(float, __builtin_amdgcn_readlane(b, 0)) + __builtin_bit_cast(float, __builtin_amdgcn_readlane(b, 16)))
         + (__builtin_bit_cast(float, __builtin_amdgcn_readlane(b, 32)) + __builtin_bit_cast(float, __builtin_amdgcn_readlane(b, 48)));
}
__device__ __forceinline__ void unpack8(const u32x4 w, float (&f)[8]) {
    f[0] = __builtin_bit_cast(float, w.x << 16); f[1] = __builtin_bit_cast(float, w.x & 0xffff0000u);
    f[2] = __builtin_bit_cast(float, w.y << 16); f[3] = __builtin_bit_cast(float, w.y & 0xffff0000u);
    f[4] = __builtin_bit_cast(float, w.z << 16); f[5] = __builtin_bit_cast(float, w.z & 0xffff0000u);
    f[6] = __builtin_bit_cast(float, w.w << 16); f[7] = __builtin_bit_cast(float, w.w & 0xffff0000u);
}
__device__ __forceinline__ u32x4 pack8(const float (&f)[8]) { u32x4 w; w.x = pk2(f[0], f[1]); w.y = pk2(f[2], f[3]); w.z = pk2(f[4], f[5]); w.w = pk2(f[6], f[7]); return w; }
__device__ __forceinline__ int cond_of_row(int r) { return r < NCTX ? 0 : 1 + ((r - NCTX) >> 11); }

__device__ __forceinline__ void transpose_item(const float* W, int N, bf16* WT, int dpitch, int k0, int n0, int drow0, LAS float* scr, int lane) {
    float tv[32];
#pragma unroll
    for (int i = 0; i < 32; ++i) tv[i] = ((const GAS float*)W)[(size_t)(k0 + 2 * i + (lane >> 5)) * N + n0 + (lane & 31)];
#pragma unroll
    for (int i = 0; i < 32; ++i) scr[(2 * i + (lane >> 5)) * 33 + (lane & 31)] = tv[i];
    asm volatile("s_waitcnt lgkmcnt(0)" ::: "memory");
    const int c = lane & 7;
#pragma unroll
    for (int j = 0; j < 4; ++j) { const int n = (lane >> 3) + 8 * j; const LAS float* s = scr + (8 * c) * 33 + n;
        u32x4 o; o.x = pk2(s[0 * 33], s[1 * 33]); o.y = pk2(s[2 * 33], s[3 * 33]); o.z = pk2(s[4 * 33], s[5 * 33]); o.w = pk2(s[6 * 33], s[7 * 33]);
        *(u32x4*)(WT + (size_t)(drow0 + n) * dpitch + k0 + 8 * c) = o; }
    asm volatile("s_waitcnt lgkmcnt(0)" ::: "memory");
}

__device__ __forceinline__ void p0_transposes(const Args& a, LAS unsigned char* lds, int gw, int NGW, int wave, int lane) {
    LAS float* scr = (LAS float*)(lds + wave * 16384);
    unsigned char* ws = a.ws;
    constexpr int I_WIN = 16 * 35, I_QB = 3 * 24, I_KVB = 2 * 32, I_SQ = 16 * 32, I_W1 = 16 * 128, I_W2 = 64 * 32;
    constexpr int NITEMS = 2 * (I_WIN + I_QB + I_KVB + I_SQ + I_SQ + I_SQ) + 4 * (I_W1 + I_W2);
    for (int it = gw; it < NITEMS; it += NGW) {
        int r = it;
        if (r < 4 * I_W1) { const int l = r / I_W1; r %= I_W1; const int kb = r / 128, nb = r % 128;
            transpose_item(a.mlp_w1 + (size_t)l * DM * FF, FF, (bf16*)(ws + WS_W1) + (size_t)l * FF * DM, DM, 64 * kb, 32 * nb, 32 * nb, scr, lane); continue; } r -= 4 * I_W1;
        if (r < 4 * I_W2) { const int l = r / I_W2; r %= I_W2; const int kb = r / 32, nb = r % 32;
            transpose_item(a.mlp_w2 + (size_t)l * FF * DM, DM, (bf16*)(ws + WS_W2) + (size_t)l * DM * FF, FF, 64 * kb, 32 * nb, 32 * nb, scr, lane); continue; } r -= 4 * I_W2;
        if (r < 2 * I_WIN) { const int l = r / I_WIN; r %= I_WIN; const int kb = r / 35, nb = r % 35;
            transpose_item(a.attn_w_in + (size_t)l * DM * AIN, AIN, (bf16*)(ws + WS_WIN) + (size_t)l * AINP * DM, DM, 64 * kb, 32 * nb, 32 * nb, scr, lane); continue; } r -= 2 * I_WIN;
        if (r < 2 * I_QB) { const int l = r / I_QB; r %= I_QB; const int kb = r / 24, nb = r % 24;
            transpose_item(a.mla_w_qb + (size_t)l * 192 * 768, 768, (bf16*)(ws + WS_WQB) + (size_t)l * 768 * 256, 256, 64 * kb, 32 * nb, 32 * nb, scr, lane); continue; } r -= 2 * I_QB;
        if (r < 2 * I_KVB) { const int l = r / I_KVB; r %= I_KVB; const int kb = r / 32, nb = r % 32;
            transpose_item(a.mla_w_kvb + (size_t)l * 128 * 1024, 1024, (bf16*)(ws + WS_WKVB) + (size_t)l * 1024 * 128, 128, 64 * kb, 32 * nb, 32 * nb, scr, lane); continue; } r -= 2 * I_KVB;
        if (r < 2 * I_SQ) { const int l = r / I_SQ; r %= I_SQ; const int kb = r / 32, nb = r % 32;
            transpose_item(a.attn_w_out + (size_t)l * DM * DM, DM, (bf16*)(ws + WS_WOUT) + (size_t)l * DM * DM, DM, 64 * kb, 32 * nb, 32 * nb, scr, lane); continue; } r -= 2 * I_SQ;
        if (r < 2 * I_SQ) { const int l = r / I_SQ; r %= I_SQ; const int kb = r / 32, nb = r % 32;
            transpose_item(a.conv_w_out + (size_t)l * DM * DM, DM, (bf16*)(ws + WS_COUT) + (size_t)l * DM * DM, DM, 64 * kb, 32 * nb, 32 * nb, scr, lane); continue; } r -= 2 * I_SQ;
        { const int l = r / I_SQ; r %= I_SQ; const int kb = r / 32, nb = r % 32; const int n0 = 32 * nb;
            const int drow = n0 < 512 ? 256 * (n0 >> 7) + (n0 & 127) : 256 * ((n0 - 512) >> 7) + 128 + ((n0 - 512) & 127);
            transpose_item(a.conv_w_in + (size_t)l * DM * 1536, 1536, (bf16*)(ws + WS_CIN) + (size_t)l * 1536 * DM, DM, 64 * kb, n0, drow, scr, lane); }
    }
    for (int i = gw * 64 + lane; i < 7 * T / 4; i += NGW * 64) *((f32x4*)(ws + WS_ROWSQ) + T / 4 + i) = (f32x4){0.f, 0.f, 0.f, 0.f};
    for (int i = gw * 64 + lane; i < 2 * 768 * 8; i += NGW * 64) { const int row = i >> 3, ch = i & 7;
        *(u32x4*)((bf16*)(ws + WS_WQB) + (size_t)row * 256 + 192 + ch * 8) = (u32x4){0u, 0u, 0u, 0u}; }
}

__device__ __forceinline__ void p0_fold(const Args& a, LAS unsigned char* lds, int bid, int G, int tid) {
    LAS float* Wl = (LAS float*)lds;
    LAS float* Pl = (LAS float*)(lds + 16384);
    for (int u = bid; u < 256; u += G) {
        const int j = u >> 7, g = (u >> 5) & 3, kc = u & 31, k0 = kc * 32;
        const float* Wsrc = a.conv_w_in + (size_t)j * DM * 1536 + 1024 + g * 128;
        const float* Psrc = a.pool_w + (size_t)(j * 4 + g) * 128 * 128;
        for (int i = tid; i < 32 * 128; i += NTHREADS) Wl[i] = Wsrc[(size_t)(k0 + (i >> 7)) * 1536 + (i & 127)];
        for (int i = tid; i < 128 * 128; i += NTHREADS) Pl[i] = Psrc[i];
        __syncthreads();
        const int d = tid & 127, kq = tid >> 7;
        float acc[8];
#pragma unroll
        for (int i = 0; i < 8; ++i) acc[i] = 0.f;
        for (int c = 0; c < 128; ++c) { const float p = Pl[c * 128 + d];
#pragma unroll
            for (int i = 0; i < 8; ++i) acc[i] += Wl[(kq * 8 + i) * 128 + c] * p; }
        const float sc = a.pool_scale[j * 512 + g * 128 + d];
#pragma unroll
        for (int i = 0; i < 8; ++i) acc[i] *= sc;
        *(u32x4*)((bf16*)(a.ws + WS_CIN) + (size_t)j * 1536 * DM + (size_t)(1024 + g * 128 + d) * DM + k0 + kq * 8) = pack8(acc);
        __syncthreads();
    }
}

__device__ __forceinline__ void p0_adaln(const Args& a, LAS unsigned char* lds, int bid, int G, int tid) {
    LAS float* sc = (LAS float*)lds;
    LAS float* red = (LAS float*)(lds + 40960);
    for (int i = tid; i < 9 * 1024; i += NTHREADS) { const int cnd = i >> 10, k = i & 1023; const float v = cnd == 0 ? a.c_ctx[k] : a.c[(cnd - 1) * 1024 + k];
        sc[k * 9 + cnd] = v / (1.0f + __expf(-v)); }
    __syncthreads();
    const int col = tid & 63, kg = tid >> 6;
    for (int u = bid; u < 4 * 96; u += G) {
        const int l = u / 96, n0 = (u % 96) * 64;
        const float* w = a.w_mod + (size_t)l * DM * 6144 + n0 + col;
        float acc[9];
#pragma unroll
        for (int c = 0; c < 9; ++c) acc[c] = 0.f;
        for (int k = kg * 128; k < kg * 128 + 128; k += 32) {
            float wv[32];
#pragma unroll
            for (int i = 0; i < 32; ++i) wv[i] = ((const GAS float*)w)[(size_t)(k + i) * 6144];
#pragma unroll
            for (int i = 0; i < 32; ++i)
#pragma unroll
                for (int c = 0; c < 9; ++c) acc[c] += sc[(k + i) * 9 + c] * wv[i];
        }
#pragma unroll
        for (int c = 0; c < 9; ++c) red[(kg * 9 + c) * 64 + col] = acc[c];
        __syncthreads();
        for (int i = tid; i < 9 * 64; i += NTHREADS) { const int c = i >> 6, cc = i & 63; float s = a.b_mod[l * 6144 + n0 + cc];
#pragma unroll
            for (int q = 0; q < 8; ++q) s += red[(q * 9 + c) * 64 + cc];
            ((float*)(a.ws + WS_MOD))[(size_t)(l * 9 + c) * 6144 + n0 + cc] = s; }
        __syncthreads();
    }
}

__device__ __forceinline__ void prep_pass(const Args& a, int gw, int NGW, int lane) {
    const float* MOD = (const float*)(a.ws + WS_MOD);
    const float* g = a.norm_g;
    float* X = (float*)(a.ws + WS_X); bf16* H = (bf16*)(a.ws + WS_H); float* RSQ = (float*)(a.ws + WS_ROWSQ);
    f32x4 v[4], vn[4], sv[4], svn[4], ggv[4];
#pragma unroll
    for (int j = 0; j < 4; ++j) { ggv[j] = ((const GAS f32x4*)g + lane)[64 * j]; sv[j] = ggv[j]; svn[j] = ggv[j]; vn[j] = ggv[j]; v[j] = ggv[j]; }
#define PREP_LOAD(dst, sdst, r_) do { const float* src_ = (r_) < NCTX ? a.x_prompt + (size_t)(r_) * DM : a.x_sample + (size_t)((r_) - NCTX) * DM; \
        const float* sc_ = MOD + (size_t)cond_of_row(r_) * 6144 + 1024; \
        _Pragma("unroll") for (int j = 0; j < 4; ++j) { dst[j] = ((const GAS f32x4*)src_ + lane)[64 * j]; sdst[j] = ((const GAS f32x4*)sc_ + lane)[64 * j]; } } while (0)
    if (gw < T) PREP_LOAD(v, sv, gw);
    for (int r = gw; r < T; r += NGW) {
        if (r + NGW < T) PREP_LOAD(vn, svn, r + NGW);
        float s = 0.f;
#pragma unroll
        for (int j = 0; j < 4; ++j) s += (v[j].x * v[j].x + v[j].y * v[j].y) + (v[j].z * v[j].z + v[j].w * v[j].w);
        s = wave_sum(s, lane);
        if (lane == 0) RSQ[r] = s;
        GAS unsigned long long* o8 = (GAS unsigned long long*)(H + (size_t)r * DM) + lane; GAS f32x4* xo = (GAS f32x4*)(X + (size_t)r * DM) + lane;
#pragma unroll
        for (int j = 0; j < 4; ++j) { const f32x4 h = v[j] * ggv[j] * (sv[j] + 1.0f);
            o8[64 * j] = (unsigned long long)pk2(h.x, h.y) | ((unsigned long long)pk2(h.z, h.w) << 32); xo[64 * j] = v[j]; }
#pragma unroll
        for (int j = 0; j < 4; ++j) { v[j] = vn[j]; sv[j] = svn[j]; }
    }
#undef PREP_LOAD
    constexpr int NB4 = (2 * 1280 + 2 * 1536 + 4 * 4096) / 4;
    for (int it = gw; it < NB4; it += NGW) {
        int r = it * 4, s, n; const bf16* wt;
        if (r < 4 * 4096) { const int l = r >> 12; n = r & 4095; s = 2 * l + 1; wt = (const bf16*)(a.ws + WS_W1) + (size_t)l * FF * DM; }
        else { r -= 4 * 4096;
            if (r < 2 * 1280) { const int li = r / 1280; n = r % 1280; s = 4 * li; wt = (const bf16*)(a.ws + WS_WIN) + (size_t)li * AINP * DM; }
            else { r -= 2 * 1280; const int lj = r / 1536; n = r % 1536; s = 4 * lj + 2; wt = (const bf16*)(a.ws + WS_CIN) + (size_t)lj * 1536 * DM; } }
        u32x4 wr0[4], wr1[4];
#pragma unroll
        for (int q = 0; q < 4; ++q) { wr0[q] = *(const GAS u32x4*)(wt + (size_t)(n + q) * DM + 16 * lane); wr1[q] = *(const GAS u32x4*)(wt + (size_t)(n + q) * DM + 16 * lane + 8); }
        float w[4][16];
#pragma unroll
        for (int q = 0; q < 4; ++q) { float t0[8], t1[8]; unpack8(wr0[q], t0); unpack8(wr1[q], t1);
#pragma unroll
            for (int e = 0; e < 8; ++e) { w[q][e] = t0[e]; w[q][8 + e] = t1[e]; } }
        const float* shb = MOD + (size_t)(s >> 1) * 9 * 6144 + ((s & 1) ? 3 : 0) * 1024 + 16 * lane;
        f32x4 outv = (f32x4){0.f, 0.f, 0.f, 0.f};
#pragma unroll
        for (int c = 0; c < 9; ++c) { const f32x4* sp = (const f32x4*)(shb + (size_t)c * 6144); const f32x4 s0 = sp[0], s1 = sp[1], s2 = sp[2], s3 = sp[3];
#pragma unroll
            for (int q = 0; q < 4; ++q) {
                float d = (s0.x * w[q][0] + s0.y * w[q][1] + s0.z * w[q][2] + s0.w * w[q][3]) + (s1.x * w[q][4] + s1.y * w[q][5] + s1.z * w[q][6] + s1.w * w[q][7])
                        + (s2.x * w[q][8] + s2.y * w[q][9] + s2.z * w[q][10] + s2.w * w[q][11]) + (s3.x * w[q][12] + s3.y * w[q][13] + s3.z * w[q][14] + s3.w * w[q][15]);
                d = wave_sum(d, lane); if (lane == c) outv[q] = d; } }
        if (lane < 9) *(f32x4*)((float*)(a.ws + WS_BIAS) + (size_t)(s * 9 + lane) * 4096 + n) = outv;
    }
}
__device__ __forceinline__ void final_norm(const Args& a, const float* P, int gw, int NGW, int lane) {
    const float* X = (const float*)(a.ws + WS_X); (void)P;
    f32x4 v[4], vn[4];
    f32x4 fgv[4];
#pragma unroll
    for (int j = 0; j < 4; ++j) fgv[j] = ((const GAS f32x4*)a.final_g + lane)[64 * j];
#define FN_LOAD(dst, r_) do { _Pragma("unroll") for (int j = 0; j < 4; ++j) dst[j] = ((const GAS f32x4*)(X + (size_t)(r_) * DM) + lane)[64 * j]; } while (0)
    if (gw < T) FN_LOAD(v, gw);
    for (int r = gw; r < T; r += NGW) {
        if (r + NGW < T) FN_LOAD(vn, r + NGW);
        float s = 0.f;
#pragma unroll
        for (int j = 0; j < 4; ++j) s += (v[j].x * v[j].x + v[j].y * v[j].y) + (v[j].z * v[j].z + v[j].w * v[j].w);
        const float rstd = 1.0f / sqrtf(wave_sum(s, lane) * (1.0f / DM) + EPS);
        GAS f32x4* o = (GAS f32x4*)(a.out + OUT_Y + (size_t)r * DM) + lane;
#pragma unroll
        for (int j = 0; j < 4; ++j) o[64 * j] = v[j] * rstd * fgv[j];
#pragma unroll
        for (int j = 0; j < 4; ++j) v[j] = vn[j];
    }
#undef FN_LOAD
}

__device__ __forceinline__ void rope8(float (&x1)[8], float (&x2)[8], float pos, int j0, float quarter_inv) {
#pragma unroll
    for (int e = 0; e < 8; ++e) { const float rev = pos * exp2f(-(float)(j0 + e) * 13.287712379549449f * quarter_inv) * 0.15915494309189535f;
        const float c = __builtin_amdgcn_cosf(rev), s = __builtin_amdgcn_sinf(rev); const float a = x1[e], b = x2[e]; x1[e] = a * c - b * s; x2[e] = a * s + b * c; }
}
__device__ __forceinline__ void store8f(float* p, const float (&f)[8]) { *(f32x4*)p = (f32x4){f[0], f[1], f[2], f[3]}; *(f32x4*)(p + 4) = (f32x4){f[4], f[5], f[6], f[7]}; }
__device__ __forceinline__ void post_pass(const Args& a, int li, int gw, int NGW, int lane) {
    unsigned char* ws = a.ws;
    const bf16* PROJ = (const bf16*)(ws + WS_PROJ); bf16* Qa = (bf16*)(ws + WS_QA); bf16* Ka = (bf16*)(ws + WS_KA); bf16* Va = (bf16*)(ws + WS_VA);
    bf16* CQN = (bf16*)(ws + WS_CQN); bf16* CKVN = (bf16*)(ws + WS_CKVN); bf16* KRR = (bf16*)(ws + WS_KRR);
    int oa0 = -1, oa1 = -1, on = -1;
    if (lane < 40) { oa0 = (lane < 32 ? 0 : 512) + ((lane < 32 ? lane : lane - 32) >> 2) * 64 + (lane & 3) * 8; oa1 = oa0 + 32; }
    else if (lane < 56) oa0 = 640 + (lane - 40) * 8;
    else if (lane < 58) { oa0 = 1088 + (lane - 56) * 8; oa1 = oa0 + 16; }
    if (lane < 24) on = 768 + lane * 8; else if (lane < 40) on = 960 + (lane - 24) * 8;
    float gnv[8];
#pragma unroll
    for (int e = 0; e < 8; ++e) gnv[e] = lane < 24 ? a.mla_q_norm[li * 192 + lane * 8 + e] : (lane < 40 ? a.mla_kv_norm[li * 128 + (lane - 24) * 8 + e] : 0.f);
    u32x4 ua0 = (u32x4){0u, 0u, 0u, 0u}, ua1 = ua0, un = ua0, na0 = ua0, na1 = ua0, nn = ua0;
#define PP_LOAD(d0_, d1_, dn_, r_) do { const GAS bf16* p_ = (const GAS bf16*)PROJ + (size_t)(r_) * AINP; \
        if (oa0 >= 0) d0_ = *(const GAS u32x4*)(p_ + oa0); if (oa1 >= 0) d1_ = *(const GAS u32x4*)(p_ + oa1); if (on >= 0) dn_ = *(const GAS u32x4*)(p_ + on); } while (0)
    if (gw < T) PP_LOAD(ua0, ua1, un, gw);
    for (int r = gw; r < TR; r += NGW) {
        if (r + NGW < T) PP_LOAD(na0, na1, nn, r + NGW);
        if (r >= T) {
            const int idx = r - T, b = idx >> 8, p = idx & 255; const size_t src = (size_t)((b * 2 + li) * 256 + p);
            const float* ck = a.cache_win_k + src * 128 + 2 * lane; const float* cv = a.cache_win_v + src * 128 + 2 * lane; const float* cc = a.cache_mla_ckv + src * 128 + 2 * lane;
            *(unsigned*)(Ka + (size_t)r * 128 + 2 * lane) = pk2(ck[0], ck[1]);
            *(unsigned*)(Va + (size_t)r * 128 + 2 * lane) = pk2(cv[0], cv[1]);
            *(unsigned*)(CKVN + (size_t)r * 128 + 2 * lane) = pk2(cc[0], cc[1]);
            if (lane < 16) { const float* cr = a.cache_mla_krope + src * 32 + 2 * lane; *(unsigned*)(KRR + (size_t)r * 32 + 2 * lane) = pk2(cr[0], cr[1]); }
            continue;
        }
        const bf16* p = PROJ + (size_t)r * AINP;
        const bool lat = r >= NCTX; const int t = lat ? ((r - NCTX) & 2047) : (r & 255);
        const float prow = (float)(t >> 6), pcol = (float)(t & 63);
        const size_t obase = (size_t)(((r >> 8) * 2 + li) * 256 + t);
        if (lane < 40) {
            const bool isq = lane < 32; const int hd = isq ? (lane >> 2) : ((lane - 32) >> 2), pc = lane & 3;
            const bf16* s1 = p + (isq ? 0 : 512) + hd * 64 + pc * 8;
            float x1[8], x2[8]; unpack8(ua0, x1); unpack8(ua1, x2); (void)s1;
            if (!isq && !lat) { float* o = a.out + OUT_K + obase * 128 + hd * 64 + pc * 8; store8f(o, x1); store8f(o + 32, x2); }
            if (lat) rope8(x1, x2, pc < 2 ? prow : pcol, (pc & 1) * 8, 1.0f / 16.0f);
            if (isq) {
#pragma unroll
                for (int e = 0; e < 8; ++e) { x1[e] *= QS_A; x2[e] *= QS_A; }
                bf16* d = Qa + (size_t)r * 512 + hd * 64 + pc * 8; *(u32x4*)d = pack8(x1); *(u32x4*)(d + 32) = pack8(x2);
            } else { bf16* d = Ka + (size_t)r * 128 + hd * 64 + pc * 8; *(u32x4*)d = pack8(x1); *(u32x4*)(d + 32) = pack8(x2); }
        } else if (lane < 56) {
            const int c = lane - 40; const u32x4 w = ua0;
            *(u32x4*)(Va + (size_t)r * 128 + c * 8) = w;
            if (!lat) { float f[8]; unpack8(w, f); store8f(a.out + OUT_V + obase * 128 + c * 8, f); }
        } else if (lane < 58) {
            const int pc = lane - 56; float x1[8], x2[8]; unpack8(ua0, x1); unpack8(ua1, x2);
            if (!lat) { float* o = a.out + OUT_KR + obase * 32 + pc * 8; store8f(o, x1); store8f(o + 16, x2); }
            if (lat) rope8(x1, x2, pc == 0 ? prow : pcol, 0, 1.0f / 8.0f);
            bf16* d = KRR + (size_t)r * 32 + pc * 8; *(u32x4*)d = pack8(x1); *(u32x4*)(d + 16) = pack8(x2);
        }
        float v[8]; float ss = 0.f;
        const bool iscq = lane < 24, isckv = lane >= 24 && lane < 40;
        if (iscq || isckv) unpack8(un, v);
        else {
#pragma unroll
            for (int e = 0; e < 8; ++e) v[e] = 0.f; }
#pragma unroll
        for (int e = 0; e < 8; ++e) ss += v[e] * v[e];
        const float sq = wave_sum(iscq ? ss : 0.f, lane), skv = wave_sum(isckv ? ss : 0.f, lane);
        if (iscq) { const float rs = 1.0f / sqrtf(sq * (1.0f / 192.0f) + EPS);
#pragma unroll
            for (int e = 0; e < 8; ++e) v[e] = v[e] * rs * gnv[e];
            *(u32x4*)(CQN + (size_t)r * 256 + lane * 8) = pack8(v);
        } else if (isckv) { const float rs = 1.0f / sqrtf(skv * (1.0f / 128.0f) + EPS);
#pragma unroll
            for (int e = 0; e < 8; ++e) v[e] = v[e] * rs * gnv[e];
            *(u32x4*)(CKVN + (size_t)r * 128 + (lane - 24) * 8) = pack8(v);
            if (!lat) store8f(a.out + OUT_CKV + obase * 128 + (lane - 24) * 8, v);
        } else if (lane < 48) { unsigned z0 = 0u; asm volatile("" : "+v"(z0)); *(u32x4*)(CQN + (size_t)r * 256 + 192 + (lane - 40) * 8) = (u32x4){z0, z0, z0, z0}; }
        ua0 = na0; ua1 = na1; un = nn;
    }
#undef PP_LOAD
}

typedef short v4i16_t __attribute__((ext_vector_type(4)));
__device__ __forceinline__ int crow(int r, int hi) { return (r & 3) + 8 * (r >> 2) + 4 * hi; }
__device__ __forceinline__ s16x4 vtr(const LAS unsigned char* p) { return __builtin_bit_cast(s16x4, __builtin_amdgcn_ds_read_tr16_b64_v4i16((LAS v4i16_t*)p)); }
typedef float f32x2_t __attribute__((ext_vector_type(2))); typedef __bf16 bf16x2_t __attribute__((ext_vector_type(2)));
__device__ __forceinline__ unsigned cvtpk(float lo, float hi) { f32x2_t v = {lo, hi}; bf16x2_t b = __builtin_convertvector(v, bf16x2_t); return __builtin_bit_cast(unsigned, b); }

constexpr int ATT_KBUF = 0, ATT_KBYTES = 64 * 208, ATT_VBUF = 2 * ATT_KBYTES, ATT_VBYTES = 8192, ATT_WSF = ATT_VBUF + 2 * ATT_VBYTES, ATT_OST = ATT_WSF + NWAVES * 256, ATT_END = ATT_OST + NWAVES * 4096;
static_assert(ATT_END <= 131072, "attention LDS");

struct AttnUnitDesc {
    const bf16* Qw; int qpitch;
    const bf16* K1; int k1p;
    const bf16* K2; int k2p;
    const bf16* V; int vp;
    int row0a, nta, row0b, ntb;
    bf16* Ow;
    float sink_l2; int has_sink;
    int win; int qpos0; int kpos0;
};

template <int DQ>
__device__ __forceinline__ void attn_unit(LAS unsigned char* lds, const AttnUnitDesc& U, int tid, int wave, int lane) {
    constexpr int KP = DQ * 2 + 16, ND = DQ / 16;
    const int r32 = lane & 31, hi = lane >> 5;
    LAS float* wsf = (LAS float*)(lds + ATT_WSF + wave * 256);
    bf16x8 qr[ND];
#pragma unroll
    for (int d0 = 0; d0 < ND; ++d0) qr[d0] = *(const GAS bf16x8*)(U.Qw + (size_t)r32 * U.qpitch + d0 * 16 + hi * 8);
    f32x16 o[2];
#pragma unroll
    for (int i = 0; i < 16; ++i) { o[0][i] = 0.f; o[1][i] = 0.f; }
    float m = 0.f, l = 0.f;
    const int ntot = U.nta + U.ntb;
    const int skey = tid >> 3, sch = tid & 7;
    u32x4 kreg, vreg, k2reg;
#define ATT_GLOAD(j) do { const int row_ = ((j) < U.nta ? U.row0a + 64 * (j) : U.row0b + 64 * ((j) - U.nta)); \
        kreg = *(const GAS u32x4*)(U.K1 + (size_t)(row_ + skey) * U.k1p + sch * 8); \
        vreg = *(const GAS u32x4*)(U.V + (size_t)(row_ + skey) * U.vp + sch * 8); \
        if (DQ == 96) { if (tid < 256) k2reg = *(const GAS u32x4*)(U.K2 + (size_t)(row_ + (tid >> 2)) * U.k2p + (tid & 3) * 8); } } while (0)
#define ATT_LSTORE(buf) do { \
        *(LAS u32x4*)(lds + ATT_KBUF + (buf) * ATT_KBYTES + skey * KP + sch * 16) = kreg; \
        *(LAS u32x4*)(lds + ATT_VBUF + (buf) * ATT_VBYTES + (sch >> 2) * 4096 + skey * 64 + (sch & 3) * 16) = vreg; \
        if (DQ == 96) { if (tid < 256) *(LAS u32x4*)(lds + ATT_KBUF + (buf) * ATT_KBYTES + (tid >> 2) * KP + 128 + (tid & 3) * 16) = k2reg; } } while (0)
    ATT_GLOAD(0); ATT_LSTORE(0);
    __syncthreads();
    for (int j = 0; j < ntot; ++j) {
        const int buf = j & 1;
        if (j + 1 < ntot) ATT_GLOAD(j + 1);
        bool skip = false, masked = false; int kp_lo = 0;
        if (U.win && j < U.nta) { kp_lo = U.kpos0 + 64 * j;
            skip = (kp_lo + 63 < U.qpos0 - 128) || (kp_lo > U.qpos0 + 31 + 128);
            masked = !((kp_lo >= U.qpos0 + 31 - 128) && (kp_lo + 63 <= U.qpos0 + 128)); }
        if (!skip) {
            const LAS unsigned char* Kt = lds + ATT_KBUF + buf * ATT_KBYTES + r32 * KP + hi * 16;
            f32x16 p0, p1;
            { const float nm = -m;
#pragma unroll
            for (int i = 0; i < 16; ++i) { p0[i] = nm; p1[i] = nm; } }
            const LAS unsigned char* Vt = lds + ATT_VBUF + buf * ATT_VBYTES + ((lane >> 4) & 1) * 32 + (lane & 3) * 8 + (4 * hi + ((lane & 15) >> 2)) * 64;
            bf16x8 ka[3][2]; s16x4 vl[3][2];
#define ATT_KLD(d_) do { ka[(d_) % 3][0] = *(const LAS bf16x8*)(Kt + (d_) * 32); ka[(d_) % 3][1] = *(const LAS bf16x8*)(Kt + 32 * KP + (d_) * 32); } while (0)
#define ATT_VLD(i_) do { vl[(i_) % 3][0] = vtr(Vt + ((i_) & 1) * 4096 + ((i_) >> 1) * 1024); vl[(i_) % 3][1] = vtr(Vt + ((i_) & 1) * 4096 + ((i_) >> 1) * 1024 + 512); } while (0)
            ATT_KLD(0); ATT_KLD(1);
#pragma unroll
            for (int d0 = 0; d0 < ND; ++d0) {
                if (d0 + 2 < ND) ATT_KLD(d0 + 2);
                __builtin_amdgcn_sched_barrier(0);
                p0 = __builtin_amdgcn_mfma_f32_32x32x16_bf16(ka[d0 % 3][0], qr[d0], p0, 0, 0, 0);
                p1 = __builtin_amdgcn_mfma_f32_32x32x16_bf16(ka[d0 % 3][1], qr[d0], p1, 0, 0, 0);
                __builtin_amdgcn_sched_barrier(0);
            }
            ATT_VLD(0); ATT_VLD(1);
            __builtin_amdgcn_sched_barrier(0);
            if (masked) { const int qp = U.qpos0 + r32;
#pragma unroll
                for (int i = 0; i < 16; ++i) { const int kp = kp_lo + crow(i, hi); const int d0_ = qp - kp, d1_ = qp - (kp + 32);
                    if (d0_ > 128 || d0_ < -128) p0[i] = NEGBIG; if (d1_ > 128 || d1_ < -128) p1[i] = NEGBIG; } }
            float mt = __builtin_fmaxf(p0[0], p1[0]);
#pragma unroll
            for (int i = 1; i < 16; ++i) mt = __builtin_fmaxf(__builtin_fmaxf(mt, p0[i]), p1[i]);
            mt = __builtin_fmaxf(mt, shfl_xor_l(mt, lane, 32));
            if (__any(mt > 8.0f)) {
                const float dl = __builtin_fmaxf(mt, 0.f); m += dl;
                const float alpha = __builtin_amdgcn_exp2f(-dl); l *= alpha;
#pragma unroll
                for (int i = 0; i < 16; ++i) { p0[i] -= dl; p1[i] -= dl; }
                if (hi == 0) wsf[r32] = alpha;
                asm volatile("s_waitcnt lgkmcnt(0)" ::: "memory");
#pragma unroll
                for (int i = 0; i < 16; ++i) { const float f = wsf[crow(i, hi)]; o[0][i] *= f; o[1][i] *= f; }
            }
            float ls = 0.f;
#pragma unroll
            for (int i = 0; i < 16; ++i) { p0[i] = __builtin_amdgcn_exp2f(p0[i]); p1[i] = __builtin_amdgcn_exp2f(p1[i]); ls += p0[i] + p1[i]; }
            l += ls;
            u32x4 pw[4];
#pragma unroll
            for (int s = 0; s < 2; ++s) {
                pw[s] = (u32x4){cvtpk(p0[8 * s], p0[8 * s + 1]), cvtpk(p0[8 * s + 2], p0[8 * s + 3]), cvtpk(p0[8 * s + 4], p0[8 * s + 5]), cvtpk(p0[8 * s + 6], p0[8 * s + 7])};
                pw[2 + s] = (u32x4){cvtpk(p1[8 * s], p1[8 * s + 1]), cvtpk(p1[8 * s + 2], p1[8 * s + 3]), cvtpk(p1[8 * s + 4], p1[8 * s + 5]), cvtpk(p1[8 * s + 6], p1[8 * s + 7])};
            }
            __builtin_amdgcn_sched_barrier(0);
#pragma unroll
            for (int i = 0; i < 8; ++i) {
                if (i + 2 < 8) ATT_VLD(i + 2);
                __builtin_amdgcn_sched_barrier(0);
                const s16x4 lo = vl[i % 3][0], hh = vl[i % 3][1];
                const bf16x8 vf = (bf16x8){lo[0], lo[1], lo[2], lo[3], hh[0], hh[1], hh[2], hh[3]};
                o[i & 1] = __builtin_amdgcn_mfma_f32_32x32x16_bf16(__builtin_bit_cast(bf16x8, pw[i >> 1]), vf, o[i & 1], 0, 0, 0);
                __builtin_amdgcn_sched_barrier(0);
            }
#undef ATT_KLD
#undef ATT_VLD
        }
        if (j + 1 < ntot) ATT_LSTORE(buf ^ 1);
        __syncthreads();
    }
    l += shfl_xor_l(l, lane, 32);
    if (U.has_sink) l += __builtin_amdgcn_exp2f(U.sink_l2 - m);
    if (hi == 0) wsf[32 + r32] = 1.0f / l;
    asm volatile("s_waitcnt lgkmcnt(0)" ::: "memory");
    LAS bf16* stg = (LAS bf16*)(lds + ATT_OST + wave * 4096);
#pragma unroll
    for (int i = 0; i < 16; ++i) { const int orow = crow(i, hi); const float rl = wsf[32 + orow];
        stg[orow * 64 + r32] = (bf16)f2bf(o[0][i] * rl); stg[orow * 64 + 32 + r32] = (bf16)f2bf(o[1][i] * rl); }
    asm volatile("s_waitcnt lgkmcnt(0)" ::: "memory");
#pragma unroll
    for (int i = 0; i < 4; ++i) { const int row = i * 8 + (lane >> 3), ch = lane & 7; const u32x4 v = *(const LAS u32x4*)(stg + row * 64 + ch * 8);
        *(GAS u32x4*)(U.Ow + (size_t)row * 1024 + ch * 8) = v; }
    asm volatile("s_waitcnt lgkmcnt(0)" ::: "memory");
}

__device__ __forceinline__ void attn_phase(const Args& a, int li, LAS unsigned char* lds, int bid, int G, int tid, int wave, int lane) {
    unsigned char* ws = a.ws;
    const bf16* Qa = (const bf16*)(ws + WS_QA); const bf16* Ka = (const bf16*)(ws + WS_KA); const bf16* Va = (const bf16*)(ws + WS_VA);
    const bf16* KRR = (const bf16*)(ws + WS_KRR); const bf16* Qm = (const bf16*)(ws + WS_QM); const bf16* KV = (const bf16*)(ws + WS_KV);
    bf16* O = (bf16*)(ws + WS_O);
    constexpr int NU0 = 512, NU1 = 512, NU2 = 128, NU3 = 128, NU = NU0 + NU1 + NU2 + NU3;
    const int cl = (G % 8 == 0) ? (bid % 8) * (G / 8) + bid / 8 : bid;
    for (int u = cl; u < NU; u += G) {
        AttnUnitDesc D;
        if (u < NU0) {
            const int qb = u & 7, h = (u >> 3) & 7, b = u >> 6; const int row = NCTX + b * 2048 + qb * 256 + wave * 32;
            D.Qw = Qm + (size_t)row * 768 + h * 96; D.qpitch = 768; D.K1 = KV + h * 128; D.k1p = 1024; D.K2 = KRR; D.k2p = 32; D.V = KV + h * 128 + 64; D.vp = 1024;
            D.row0a = NCTX + b * 2048; D.nta = 32; D.row0b = T + b * 256; D.ntb = 4; D.Ow = O + (size_t)row * 1024 + 512 + h * 64;
            D.sink_l2 = 0.f; D.has_sink = 0; D.win = 0; D.qpos0 = 0; D.kpos0 = 0;
            attn_unit<96>(lds, D, tid, wave, lane);
        } else if (u < NU0 + NU1) {
            const int v = u - NU0; const int pair = v & 1, nb = (v >> 1) & 15, kvh = (v >> 5) & 1, b = v >> 6;
            const int head = kvh * 4 + pair * 2 + (wave >> 2), qoff = (wave & 3) * 32; const int row = NCTX + b * 2048 + nb * 128 + qoff;
            const int kb_lo = nb > 0 ? nb - 1 : 0, kb_hi = nb + 2 < 16 ? nb + 2 : 16;
            D.Qw = Qa + (size_t)row * 512 + head * 64; D.qpitch = 512; D.K1 = Ka + kvh * 64; D.k1p = 128; D.K2 = nullptr; D.k2p = 0; D.V = Va + kvh * 64; D.vp = 128;
            D.row0a = NCTX + b * 2048 + kb_lo * 128; D.nta = (kb_hi - kb_lo) * 2; D.row0b = T + b * 256; D.ntb = 4; D.Ow = O + (size_t)row * 1024 + head * 64;
            D.sink_l2 = a.attn_sink[li * 8 + head] * LOG2E; D.has_sink = 1; D.win = 1; D.qpos0 = nb * 128 + qoff; D.kpos0 = kb_lo * 128;
            attn_unit<64>(lds, D, tid, wave, lane);
        } else if (u < NU0 + NU1 + NU2) {
            const int v = u - NU0 - NU1; const int h = v & 7, b = v >> 3; const int row = b * 256 + wave * 32;
            D.Qw = Qm + (size_t)row * 768 + h * 96; D.qpitch = 768; D.K1 = KV + h * 128; D.k1p = 1024; D.K2 = KRR; D.k2p = 32; D.V = KV + h * 128 + 64; D.vp = 1024;
            D.row0a = b * 256; D.nta = 4; D.row0b = 0; D.ntb = 0; D.Ow = O + (size_t)row * 1024 + 512 + h * 64;
            D.sink_l2 = 0.f; D.has_sink = 0; D.win = 0; D.qpos0 = 0; D.kpos0 = 0;
            attn_unit<96>(lds, D, tid, wave, lane);
        } else {
            const int v = u - NU0 - NU1 - NU2; const int head = v & 7, b = v >> 3, kvh = head >> 2; const int row = b * 256 + wave * 32;
            D.Qw = Qa + (size_t)row * 512 + head * 64; D.qpitch = 512; D.K1 = Ka + kvh * 64; D.k1p = 128; D.K2 = nullptr; D.k2p = 0; D.V = Va + kvh * 64; D.vp = 128;
            D.row0a = b * 256; D.nta = 4; D.row0b = 0; D.ntb = 0; D.Ow = O + (size_t)row * 1024 + head * 64;
            D.sink_l2 = a.attn_sink[li * 8 + head] * LOG2E; D.has_sink = 1; D.win = 0; D.qpos0 = 0; D.kpos0 = 0;
            attn_unit<64>(lds, D, tid, wave, lane);
        }
    }
}

constexpr int CV_U = 0, CV_UROWS = 46, CV_Z = CV_UROWS * 1024, CV_ZROWS = 31, CV_CV = CV_Z + CV_ZROWS * 1024, CV_END = CV_CV + 16 * 512 * 4;
static_assert(CV_END <= 131072, "conv LDS");
template <int W>
__device__ __forceinline__ void pool_lds(const LAS unsigned char* zl, int t0, int n, int c, float (&y)[16]) {
    constexpr int LO = W / 2, HI = W - LO - 1, NV = 16 + W - 1;
    float z[NV];
#pragma unroll
    for (int i = 0; i < NV; ++i) z[i] = bf2f(*(const LAS unsigned short*)(zl + (8 - LO + i) * 1024 + c * 2));
#pragma unroll
    for (int t = 0; t < 16; ++t) { const int tt = t0 + t;
        float s = 0.f;
#pragma unroll
        for (int i = 0; i < W; ++i) s += z[t + i];
        const int st = tt - LO < 0 ? 0 : tt - LO, en = tt + HI + 1 > n ? n : tt + HI + 1;
        y[t] = s / (float)(en - st) - z[t + LO]; }
}
__device__ __forceinline__ void convpool_phase(const Args& a, int lj, LAS unsigned char* lds, int bid, int G, int tid, int wave, int lane) {
    const bf16* Ub = (const bf16*)(a.ws + WS_PROJ); const bf16* ZW = Ub + (size_t)T * 512; bf16* CAT = (bf16*)(a.ws + WS_O);
    LAS float* cv = (LAS float*)(lds + CV_CV);
    const int c = tid;
    float w[31];
#pragma unroll
    for (int j = 0; j < 31; ++j) w[j] = a.conv_dw[(size_t)(lj * 31 + j) * 512 + c];
    const float bias = a.conv_dw_b[lj * 512 + c];
    float lng[8], lnb[8];
#pragma unroll
    for (int e = 0; e < 8; ++e) { lng[e] = a.conv_ln_g[lj * 512 + 8 * lane + e]; lnb[e] = a.conv_ln_b[lj * 512 + 8 * lane + e]; }
    u32x4 ur[6], zr[4];
#define CV_DECODE(u_, rs_, t0_, n_) do { if ((u_) < 256) { rs_ = (size_t)((u_) >> 4) * 256; t0_ = ((u_) & 15) * 16; n_ = 256; } \
        else { const int v_ = (u_) - 256; rs_ = (size_t)NCTX + (size_t)(v_ >> 7) * 2048; t0_ = (v_ & 127) * 16; n_ = 2048; } } while (0)
#define CV_GLOAD(u_) do { size_t rs_; int t0_, n_; CV_DECODE(u_, rs_, t0_, n_); \
        _Pragma("unroll") for (int k = 0; k < 6; ++k) { const int q = tid + 512 * k; const int tt = t0_ - 15 + (q >> 6); \
            ur[k] = (q < CV_UROWS * 64 && tt >= 0 && tt < n_) ? *(const GAS u32x4*)(Ub + (rs_ + tt) * 512 + (q & 63) * 8) : (u32x4){0u, 0u, 0u, 0u}; } \
        _Pragma("unroll") for (int k = 0; k < 4; ++k) { const int q = tid + 512 * k; const int tt = t0_ - 8 + (q >> 6); \
            zr[k] = (q < CV_ZROWS * 64 && tt >= 0 && tt < n_) ? *(const GAS u32x4*)(ZW + (rs_ + tt) * 512 + (q & 63) * 8) : (u32x4){0u, 0u, 0u, 0u}; } } while (0)
    if (bid < 1280) CV_GLOAD(bid);
    for (int u = bid; u < 1280; u += G) {
        size_t rowseq0; int t0, n; CV_DECODE(u, rowseq0, t0, n);
#pragma unroll
        for (int k = 0; k < 6; ++k) { const int q = tid + 512 * k; if (q < CV_UROWS * 64) *(LAS u32x4*)(lds + CV_U + q * 16) = ur[k]; }
#pragma unroll
        for (int k = 0; k < 4; ++k) { const int q = tid + 512 * k; if (q < CV_ZROWS * 64) *(LAS u32x4*)(lds + CV_Z + q * 16) = zr[k]; }
        __syncthreads();
        if (u + G < 1280) CV_GLOAD(u + G);
        float acc[16];
#pragma unroll
        for (int t = 0; t < 16; ++t) acc[t] = bias;
#pragma unroll
        for (int r = 0; r < 46; ++r) { const float v = bf2f(*(const LAS unsigned short*)(lds + CV_U + r * 1024 + c * 2));
#pragma unroll
            for (int t = 0; t < 16; ++t) { if (r - t >= 0 && r - t <= 30) acc[t] += w[r - t] * v; } }
#pragma unroll
        for (int t = 0; t < 16; ++t) cv[t * 512 + c] = acc[t];
        float y[16];
        { const int gi = wave >> 1; const LAS unsigned char* zl = lds + CV_Z;
          if (gi == 0) pool_lds<2>(zl, t0, n, c, y); else if (gi == 1) pool_lds<4>(zl, t0, n, c, y); else if (gi == 2) pool_lds<8>(zl, t0, n, c, y); else pool_lds<16>(zl, t0, n, c, y); }
        __syncthreads();
        LAS unsigned char* ost = lds + CV_U;
#pragma unroll
        for (int q = 0; q < 2; ++q) { const int t = 2 * wave + q;
            const f32x4 v0 = *(const LAS f32x4*)(cv + t * 512 + 8 * lane), v1 = *(const LAS f32x4*)(cv + t * 512 + 8 * lane + 4);
            float x[8] = {v0.x, v0.y, v0.z, v0.w, v1.x, v1.y, v1.z, v1.w};
            float s = 0.f;
#pragma unroll
            for (int e = 0; e < 8; ++e) s += x[e];
            const float mu = wave_sum(s, lane) * (1.0f / 512.0f); float qq = 0.f;
#pragma unroll
            for (int e = 0; e < 8; ++e) { x[e] -= mu; qq += x[e] * x[e]; }
            const float rstd = 1.0f / sqrtf(wave_sum(qq, lane) * (1.0f / 512.0f) + EPS);
#pragma unroll
            for (int e = 0; e < 8; ++e) { const float yy = x[e] * rstd * lng[e] + lnb[e]; x[e] = yy * __builtin_amdgcn_rcpf(1.0f + __expf(-yy)); }
            *(LAS u32x4*)(ost + t * 2048 + lane * 16) = pack8(x); }
#pragma unroll
        for (int t = 0; t < 16; ++t) *(LAS unsigned short*)(ost + t * 2048 + 1024 + c * 2) = (unsigned short)f2bf(y[t]);
        __syncthreads();
#pragma unroll
        for (int k = 0; k < 4; ++k) { const int q = tid + 512 * k; const int row = q >> 7, ch = q & 127;
            *(GAS u32x4*)(CAT + (rowseq0 + t0 + row) * 1024 + ch * 8) = *(const LAS u32x4*)(ost + row * 2048 + ch * 16); }
        __syncthreads();
    }
#undef CV_DECODE
#undef CV_GLOAD
}

#define XB_TMO      128
#define XB_XCNT(j)  (256  + 64 * (j))
#define XB_XSUB(j)  (1280 + 64 * (j))
#define XB_XGEN(j)  (2304 + 64 * (j))
#define XB_TOP      3328
#define XB_TOPGEN   3392
#define XCD_BAR_WORDS 3456
#define XB_SPIN_CAP (1u << 18)

__device__ __forceinline__ unsigned xb_ld(unsigned* p)              { return __hip_atomic_load(p, __ATOMIC_RELAXED, __HIP_MEMORY_SCOPE_AGENT); }
__device__ __forceinline__ unsigned xb_add(unsigned* p, unsigned v) { return __hip_atomic_fetch_add(p, v, __ATOMIC_RELAXED, __HIP_MEMORY_SCOPE_AGENT); }
__device__ __forceinline__ unsigned xb_xcc_id() { return (unsigned)__builtin_amdgcn_s_getreg((3 << 11) | 20) & 0xFu; }
#define XB_SPIN(cond, bar) do { unsigned _sp = 0; while (cond) { __builtin_amdgcn_s_sleep(1); \
    if ((++_sp & 255u) == 0u) { if (xb_ld(&(bar)[XB_TMO])) break; if (_sp > XB_SPIN_CAP) { atomicAdd(&(bar)[XB_TMO], 1u); break; } } } } while (0)

struct XcdBarrier {
    unsigned* bar; unsigned x;
    volatile LAS unsigned* st;
};

__device__ __forceinline__ XcdBarrier xcd_barrier_post(unsigned* bar, volatile LAS unsigned* st) {
    XcdBarrier b; b.bar = bar; b.x = xb_xcc_id(); b.st = st;
    if (threadIdx.x == 0) (void)xb_add(&bar[XB_XCNT(b.x)], 1u);
    return b;
}
__device__ __forceinline__ void xcd_barrier_complete(unsigned* bar, unsigned x, unsigned& nloc, unsigned& nx) {
    const unsigned G = gridDim.x * gridDim.y * gridDim.z;
    unsigned sum, cnt, mine, sp = 0u;
    for (;;) {
        sum = 0u; cnt = 0u; mine = 0u;
#pragma unroll
        for (unsigned j = 0; j < 16; ++j) { const unsigned c = xb_ld(&bar[XB_XCNT(j)]); sum += c; cnt += (c > 0u) ? 1u : 0u; mine = (j == x) ? c : mine; }
        if (sum == G) break;
        __builtin_amdgcn_s_sleep(1);
        if ((++sp & 255u) == 0u) { if (xb_ld(&bar[XB_TMO])) break; if (sp > XB_SPIN_CAP) { atomicAdd(&bar[XB_TMO], 1u); break; } }
    }
    nloc = mine > 0u ? mine : 1u; nx = cnt > 0u ? cnt : 1u;
}

__device__ __forceinline__ void xcd_barrier(const XcdBarrier& b) {
    asm volatile("s_waitcnt vmcnt(0)" ::: "memory");
    __syncthreads();
    if (threadIdx.x == 0) {
        unsigned* bar = b.bar;
        __builtin_amdgcn_s_waitcnt(0);
        unsigned nloc = b.st[0], nx = b.st[1];
        if (nloc == 0u) { xcd_barrier_complete(bar, b.x, nloc, nx); b.st[0] = nloc; b.st[1] = nx; }
        const unsigned old = xb_add(&bar[XB_XSUB(b.x)], 1u);
        const unsigned gen = old / nloc;
        if (old + 1u == (gen + 1u) * nloc) {
            __builtin_amdgcn_fence(__ATOMIC_RELEASE, "agent");
            asm volatile("s_waitcnt vmcnt(0)" ::: "memory");
            const unsigned og = xb_add(&bar[XB_TOP], 1u);
            const unsigned tg = og / nx;
            if (og + 1u == (tg + 1u) * nx) xb_add(&bar[XB_TOPGEN], 1u);
            else XB_SPIN(xb_ld(&bar[XB_TOPGEN]) == tg, bar);
            __builtin_amdgcn_fence(__ATOMIC_ACQUIRE, "agent");
            xb_add(&bar[XB_XGEN(b.x)], 1u);
            asm volatile("s_waitcnt vmcnt(0)" ::: "memory");
        } else {
            XB_SPIN(xb_ld(&bar[XB_XGEN(b.x)]) == gen, bar);
            __builtin_amdgcn_fence(__ATOMIC_ACQUIRE, "agent");
            asm volatile("s_waitcnt vmcnt(0)" ::: "memory");
        }
    }
    __syncthreads();
}

#ifndef REP_ATTN
#define REP_ATTN 1
#endif
#ifndef REP_SYNC
#define REP_SYNC 0
#endif
#ifndef REP_UP
#define REP_UP 1
#endif
#ifndef REP_NORM
#define REP_NORM 1
#endif
#ifndef REP_P0
#define REP_P0 1
#endif
#ifndef REP_CONV
#define REP_CONV 1
#endif
#ifndef REP_POST
#define REP_POST 1
#endif
#ifndef REP_DOWN
#define REP_DOWN 1
#endif
#ifndef KVB_AL
#define KVB_AL false
#endif
#ifndef KVB_SP
#define KVB_SP true
#endif
#ifndef REP_G1
#define REP_G1 1
#endif
template <class T_> struct unparen_; template <class T_> struct unparen_<void(T_)> { typedef T_ type; };
#define UNPAREN(...) typename unparen_<void(__VA_ARGS__)>::type
#define GEMM_PHASE(EpiT, Aptr, Bptr, M_, N_, K_, ...) GEMM_PHASE_F(true, true, EpiT, Aptr, Bptr, M_, N_, K_, __VA_ARGS__)
#define GEMM_PHASE_F(AL_, SP_, EpiT, Aptr, Bptr, M_, N_, K_, ...) do { typedef unparen_<void(EpiT)>::type Epi_; int kk_ = (K_); pg8::Gemm g_{(const pg8::bf16_t*)(Aptr), (const pg8::bf16_t*)(Bptr), (M_), (N_), kk_}; pg8::StaticOrder S_; S_.init((M_), (N_), (K_), G, bid); \
    Epi_ E_{__VA_ARGS__}; pg8::gemm_phase<Epi_, pg8::StaticOrder, AL_, SP_>(lds, g_, S_, E_, tid); } while (0)

#define GEMM_PHASE_RESID(Aptr, Bptr, K_, l_, gi, sn) GEMM_PHASE_RESID2(pg8::RoundSplitOrder, Aptr, Bptr, K_, l_, gi, sn, 1.0f, (float*)(ws + WS_ROWSQ) + (size_t)((sn) & 7) * T)
#define GEMM_PHASE_RESID_STATIC(Aptr, Bptr, K_, l_, gi, sn) GEMM_PHASE_RESID2(pg8::StaticOrder4, Aptr, Bptr, K_, l_, gi, sn, 1.0f, (float*)(ws + WS_ROWSQ) + (size_t)((sn) & 7) * T)
#define GEMM_PHASE_RESID2(Ord_, Aptr, Bptr, K_, l_, gi, sn, gs_, rsqp_) do { pg8::Gemm g_{(const pg8::bf16_t*)(Aptr), (const pg8::bf16_t*)(Bptr), T, DM, (K_)}; Ord_ S_; S_.init(T, DM, (K_), 4, G, bid); \
    const float* mod_ = (const float*)(ws + WS_MOD); const int sn_ = (sn); \
    pg8::EpiResid E_{(float*)(ws + WS_X), mod_ + (size_t)(l_) * 9 * 6144 + (gi) * 1024, sn_ < 8 ? (pg8::bf16_t*)(ws + WS_H) : (pg8::bf16_t*)nullptr, pa.norm_g + (size_t)(sn_ & 7) * DM, \
        mod_ + (size_t)((sn_ & 7) >> 1) * 9 * 6144 + ((sn_ & 1) ? 4 : 1) * 1024, (rsqp_), (gs_), pa.out, (unsigned*)(ws + 16384), 4u * (unsigned)(nsplit += Ord_::kSplit), (K_) / 64}; \
    pg8::gemm_phase<pg8::EpiResid, Ord_, true, true>(lds, g_, S_, E_, tid); } while (0)

__global__ void __launch_bounds__(NTHREADS, 2) trunk_fwd(Args a) {
    extern __shared__ __attribute__((aligned(16))) unsigned char lds_raw[];
    LAS unsigned char* lds = (LAS unsigned char*)lds_raw;
    cg::grid_group grid = cg::this_grid();
    const int tid0 = threadIdx.x, bid0 = blockIdx.x, G = gridDim.x, NGW = G * NWAVES;
    const int wave0 = __builtin_amdgcn_readfirstlane(tid0 >> 6);
    int ph = 0; int nsplit = 0;
    unsigned* barw = (unsigned*)a.ws;
    if (a.ph_hi < 0) grid.sync();
    volatile LAS unsigned* MISC = (volatile LAS unsigned*)(lds + 131072 + 320);
    if (tid0 < 32) MISC[tid0] = 0u;
    __syncthreads();
    XcdBarrier xbar = xcd_barrier_post(barw, MISC + 8);
#define PHASE_BEGIN if (ph >= a.ph_lo && ph < a.ph_hi) { unsigned ones_ = ~0u; asm volatile("" : "+s"(ones_)); int tid = wave0 * 64 + (int)__builtin_amdgcn_mbcnt_hi(ones_, __builtin_amdgcn_mbcnt_lo(ones_, 0u)); int bid = bid0; asm volatile("" : "+s"(bid)); unsigned char* ws = a.ws; asm volatile("" : "+s"(ws)); Args pa = a; pa.ws = ws; \
    const int lane = tid & 63, wave = __builtin_amdgcn_readfirstlane(tid >> 6), gw = bid * NWAVES + wave; (void)lane; (void)gw; (void)ws;
#define PHASE_END(dosync_) if ((dosync_) && ph + 1 < a.ph_hi) { xcd_barrier(xbar); } } ++ph;

    PHASE_BEGIN
        for (int rep_ = 0; rep_ < REP_P0; ++rep_) {
        p0_adaln(pa, lds, bid, G, tid);
        __syncthreads();
        p0_fold(pa, lds, bid, G, tid);
        __syncthreads();
        p0_transposes(pa, lds, gw, NGW, wave, lane);
        __syncthreads(); }
    PHASE_END(true)

    PHASE_BEGIN
        prep_pass(pa, gw, NGW, lane);
    PHASE_END(true)

    for (int l = 0; l < DEPTH; ++l) {
        const float* rsq0 = (const float*)(a.ws + WS_ROWSQ) + (size_t)(2 * l) * T; const float* bias0 = (const float*)(a.ws + WS_BIAS) + (size_t)(2 * l) * 9 * 4096;
        if ((l & 1) == 0) {
            const int li = l >> 1;
            PHASE_BEGIN
                GEMM_PHASE((pg8::EpiStore<0, true>), ws + WS_H, (bf16*)(ws + WS_WIN) + (size_t)li * AINP * DM, T, AINP, DM, (pg8::bf16_t*)(ws + WS_PROJ), AINP, rsq0, bias0);
            PHASE_END(true)
            PHASE_BEGIN
                post_pass(pa, li, gw, NGW, lane);
            PHASE_END(true)
            PHASE_BEGIN
                GEMM_PHASE((pg8::EpiQm), ws + WS_CQN, (bf16*)(ws + WS_WQB) + (size_t)li * 768 * 256, T, 768, 256, (pg8::bf16_t*)(ws + WS_QM), QS_M);
                GEMM_PHASE_F(KVB_AL, KVB_SP, (pg8::EpiStore<0, false>), ws + WS_CKVN, (bf16*)(ws + WS_WKVB) + (size_t)li * 1024 * 128, TR, 1024, 128, (pg8::bf16_t*)(ws + WS_KV), 1024, (const float*)nullptr, (const float*)nullptr);
            PHASE_END(true)
            PHASE_BEGIN
                for (int rep_ = 0; rep_ < REP_ATTN; ++rep_) { attn_phase(pa, li, lds, bid, G, tid, wave, lane); if (rep_ + 1 < REP_ATTN) xcd_barrier(xbar); }
            PHASE_END(true)
            PHASE_BEGIN
                GEMM_PHASE_RESID(ws + WS_O, (bf16*)(ws + WS_WOUT) + (size_t)li * DM * DM, DM, l, 2, 2 * l + 1);
            PHASE_END(true)
        } else {
            const int lj = l >> 1;
            PHASE_BEGIN
                GEMM_PHASE((pg8::EpiGlu), ws + WS_H, (bf16*)(ws + WS_CIN) + (size_t)lj * 1536 * DM, T, 1536, DM, (pg8::bf16_t*)(ws + WS_PROJ), (pg8::bf16_t*)(ws + WS_PROJ) + (size_t)T * 512, rsq0, bias0);
            PHASE_END(true)
            PHASE_BEGIN
                for (int rep_ = 0; rep_ < REP_CONV; ++rep_) { convpool_phase(pa, lj, lds, bid, G, tid, wave, lane); if (rep_ + 1 < REP_CONV) xcd_barrier(xbar); }
            PHASE_END(true)
            PHASE_BEGIN
                GEMM_PHASE_RESID(ws + WS_O, (bf16*)(ws + WS_COUT) + (size_t)lj * DM * DM, DM, l, 2, 2 * l + 1);
            PHASE_END(true)
        }
        PHASE_BEGIN
            for (int rep_ = 0; rep_ < REP_UP; ++rep_) {
            GEMM_PHASE((pg8::EpiStore<1, true>), ws + WS_H, (bf16*)(ws + WS_W1) + (size_t)l * FF * DM, T, FF, DM, (pg8::bf16_t*)(ws + WS_HID), FF, rsq0 + T, bias0 + 9 * 4096);
            }
        PHASE_END(true)
        PHASE_BEGIN
            GEMM_PHASE_RESID(ws + WS_HID, (bf16*)(ws + WS_W2) + (size_t)l * DM * FF, FF, l, 5, 2 * l + 2);
#if REP_DOWN > 1
            GEMM_PHASE_RESID2(pg8::RoundSplitOrder, ws + WS_HID, (bf16*)(ws + WS_W2) + (size_t)l * DM * FF, FF, l, 5, 2 * l + 2, 0.0f, (float*)(ws + 768 * 1024));
#endif
        PHASE_END(true)
    }
    PHASE_BEGIN
        for (int rep_ = 0; rep_ < REP_SYNC; ++rep_) xcd_barrier(xbar);
        final_norm(pa, (const float*)nullptr, gw, NGW, lane);
    PHASE_END(false)
}

extern "C" void kernel_launch(void* const* d_in, const int* in_sizes, int n_in, void* d_out, int out_size, void* d_ws, size_t ws_size, hipStream_t stream) {
    static int grid = 0;
    if (grid == 0) {
        if (n_in != 29 || (size_t)out_size != OUT_END || ws_size < WS_END) { fprintf(stderr, "kernel_launch: unexpected sizes n_in %d out %d ws %zu (need %zu)\n", n_in, out_size, ws_size, (size_t)WS_END); grid = -1; return; }
        int dev = 0, cus = 0, per_cu = 0;
        (void)hipGetDevice(&dev); (void)hipDeviceGetAttribute(&cus, hipDeviceAttributeMultiprocessorCount, dev);
        if (hipFuncSetAttribute((const void*)trunk_fwd, hipFuncAttributeMaxDynamicSharedMemorySize, LDS_BYTES) != hipSuccess) { fprintf(stderr, "kernel_launch: hipFuncSetAttribute failed\n"); grid = -1; return; }
        if (hipOccupancyMaxActiveBlocksPerMultiprocessor(&per_cu, (const void*)trunk_fwd, NTHREADS, LDS_BYTES) != hipSuccess || per_cu < 1) { fprintf(stderr, "kernel_launch: occupancy query says %d\n", per_cu); (void)hipGetLastError(); per_cu = 1; }
        if (cus < 256) { fprintf(stderr, "kernel_launch: needs 256 CUs (split-K deal), got %d\n", cus); grid = -1; return; }
        grid = 256;
    }
    if (grid < 0) return;
    if (hipMemsetAsync(d_ws, 0, 32768, stream) != hipSuccess) { fprintf(stderr, "kernel_launch: hipMemsetAsync failed\n"); return; }
    Args a{};
    const float** pp = (const float**)&a;
    for (int i = 0; i < 29; ++i) pp[i] = (const float*)d_in[i];
    a.out = (float*)d_out; a.ws = (unsigned char*)d_ws; a.ph_lo = 0; a.ph_hi = 1000;
    void* args[] = {&a};
    hipError_t e = hipLaunchCooperativeKernel((const void*)trunk_fwd, dim3(grid), dim3(NTHREADS), args, LDS_BYTES, stream);
    if (e != hipSuccess) fprintf(stderr, "cooperative launch failed: %s (grid %d)\n", hipGetErrorString(e), grid);
}
```

```cpp
#include <hip/hip_runtime.h>
#include <hip/hip_cooperative_groups.h>
#include <cstdio>
#include <cstdint>
namespace cg = cooperative_groups;
namespace pg8 {
#define PG8_LAS __attribute__((address_space(3)))
typedef unsigned short bf16_t;
typedef short bf16x8 __attribute__((ext_vector_type(8)));
typedef float f32x4 __attribute__((ext_vector_type(4)));
typedef unsigned u32x4 __attribute__((ext_vector_type(4)));
constexpr int BM = 256, BK = 64, HALF = 128, HTB = HALF * BK * 2  , STAGE_BYTES = 8 * HTB, NXCD = 8, WGM = 8;

__host__ __device__ __forceinline__ int lds_byte(int r, int c) { const int st = (r >> 4) * 2 + (c >> 5), rr = r & 15, cc = c & 31, ob = rr * 64 + cc * 2; return st * 1024 + (ob ^ (((ob >> 9) & 1) << 5)); }
__host__ __device__ __forceinline__ void stage_rc(int b, int& R, int& C) { const int st = b / 1024, sb = b % 1024, swz = sb ^ (((sb >> 9) & 1) << 5); R = (st >> 1) * 16 + swz / 64; C = (st & 1) * 32 + (swz % 64) / 2; }
__host__ __device__ __forceinline__ int perm32(int rho) { const int n = rho >> 4, i = rho & 15; return 8 * (i >> 2) + 4 * n + (i & 3); }

struct Unit { int pm, pn, k0, nt; };
struct Gemm { const bf16_t* A; const bf16_t* Bt; int M, N, K; };

struct StaticOrder {
    int nM, nN, nwg, G, c, ntk;
    __host__ __device__ __forceinline__ void init(int M, int N, int K, int G_, int c_) { nM = M / BM; nN = N / BM; nwg = nM * nN; G = G_; c = c_; ntk = K / BK; }
    __host__ __device__ __forceinline__ bool next(int i, Unit& u) const {
        const long L = (long)i * G + c; if (L >= nwg) return false;
        int wgid = (int)L; { const int q = nwg / NXCD, r = nwg % NXCD, xcd = wgid % NXCD, off = wgid / NXCD; wgid = (xcd < r ? xcd * (q + 1) : r * (q + 1) + (xcd - r) * q) + off; }
        const int nig = WGM * nN, gid = wgid / nig, fm = gid * WGM, gsz = (nM - fm) < WGM ? (nM - fm) : WGM;
        u.pm = fm + ((wgid % nig) % gsz); u.pn = (wgid % nig) / gsz; u.k0 = 0; u.nt = ntk; return true;
    }
    __device__ __forceinline__ void a_ready(const Unit&) const {}
    __device__ __forceinline__ void done(const Unit&) const {}
};

struct SplitKOrder {
    int nN, C, ntc, q0, q1;
    __host__ __device__ __forceinline__ void init(int M, int N, int K, int C_, int G_, int c_) { nN = N / BM; C = C_; ntc = K / BK / C_; const int nq = (M / BM) * nN * C_;
        const int cl = (G_ % NXCD == 0) ? (c_ % NXCD) * (G_ / NXCD) + c_ / NXCD : c_; const int per = (nq + G_ - 1) / G_; q0 = cl * per; q1 = q0 + per < nq ? q0 + per : nq; }
    __host__ __device__ __forceinline__ bool next(int i, Unit& u) const {
        int q = q0;
        for (int k = 0; k <= i; ++k) { if (q >= q1) return false; const int tile = q / C, kq = q % C; const int cnt = (C - kq) < (q1 - q) ? (C - kq) : (q1 - q);
            if (k == i) { u.pm = tile / nN; u.pn = tile % nN; u.k0 = kq * ntc * BK; u.nt = cnt * ntc; return true; } q += cnt; }
        return false;
    }
    __device__ __forceinline__ void a_ready(const Unit&) const {}
    __device__ __forceinline__ void done(const Unit&) const {}
};

struct StaticOrder4 : StaticOrder { static constexpr int kSplit = 0; __host__ __device__ __forceinline__ void init(int M, int N, int K, int, int G_, int c_) { StaticOrder::init(M, N, K, G_, c_); } };
struct RoundSplitOrder {
    static constexpr int kSplit = 1;
    int nN, C, ntk, cl, G;
    __host__ __device__ __forceinline__ void init(int M, int N, int K, int C_, int G_, int c_) { nN = N / BM; C = C_; ntk = K / BK; G = G_; (void)M;
        cl = (G_ % NXCD == 0) ? (c_ % NXCD) * (G_ / NXCD) + c_ / NXCD : c_; }
    __host__ __device__ __forceinline__ bool next(int i, Unit& u) const {
        if (i > 1) return false;
        int tile;
        const int part = cl % C; const bool split_now = ((cl / C) & 1) ? (i == 0) : (i == 1);
        if (!split_now) { tile = cl; u.k0 = 0; u.nt = ntk; } else { tile = G + cl / C; u.nt = ntk / C; u.k0 = part * u.nt * BK; }
        u.pm = tile / nN; u.pn = tile % nN; return true;
    }
    __device__ __forceinline__ void a_ready(const Unit&) const {}
    __device__ __forceinline__ void done(const Unit&) const {}
};

__device__ __forceinline__ unsigned cvt_pk_bf16(float lo, float hi) { unsigned r; asm volatile("v_cvt_pk_bf16_f32 %0, %1, %2" : "=v"(r) : "v"(lo), "v"(hi)); return r; }

typedef unsigned u32x2 __attribute__((ext_vector_type(2)));
__device__ __forceinline__ int epi_cond(int pm) { return pm < 16 ? 0 : 1 + ((pm - 16) >> 3); }
__device__ __forceinline__ float epi_rstd(const float* rowsq, int row) { return __builtin_amdgcn_rsqf(rowsq[row] * (1.0f / 1024.0f) + 1e-6f); }
template <int ACT, bool NORM> struct EpiStore {
    static constexpr bool PERM = true, AFTER_DRAIN = false;
    bf16_t* O; int ldc; const float* rowsq; const float* bias;
    __device__ __forceinline__ void operator()(const f32x4 (&acc)[2][2][4][2], const Unit& u, int wr, int wc, int fr, int fq) const {
        const int row0 = u.pm * BM + wr * 64 + fr; const int col0 = u.pn * BM + wc * 32 + 8 * fq;
        float rs[2][4];
        if (NORM) {
#pragma unroll
            for (int ai = 0; ai < 2; ++ai)
#pragma unroll
                for (int m = 0; m < 4; ++m) rs[ai][m] = epi_rstd(rowsq, row0 + ai * HALF + m * 16); }
        const float* bp = NORM ? bias + (size_t)epi_cond(u.pm) * 4096 + col0 : nullptr;
        f32x4 bb[2][2];
#pragma unroll
        for (int bj = 0; bj < 2; ++bj) { bb[bj][0] = (f32x4){0.f, 0.f, 0.f, 0.f}; bb[bj][1] = bb[bj][0];
            if (NORM) { bb[bj][0] = *(const f32x4*)(bp + bj * HALF); bb[bj][1] = *(const f32x4*)(bp + bj * HALF + 4); } }
#pragma unroll
        for (int bj = 0; bj < 2; ++bj) {
            const f32x4 b0 = bb[bj][0], b1 = bb[bj][1];
#pragma unroll
            for (int ai = 0; ai < 2; ++ai)
#pragma unroll
                for (int m = 0; m < 4; ++m) { bf16_t* rowp = O + (size_t)(row0 + ai * HALF + m * 16) * ldc + col0;
                    f32x4 v0 = acc[ai][bj][m][0], v1 = acc[ai][bj][m][1];
                    if (NORM) { v0 = v0 * rs[ai][m] + b0; v1 = v1 * rs[ai][m] + b1; }
                    if (ACT == 1) {
#pragma unroll
                        for (int j = 0; j < 4; ++j) { const float a = fmaxf(v0[j], 0.f), b = fmaxf(v1[j], 0.f); v0[j] = a * a; v1[j] = b * b; } }
                    u32x4 w; w.x = cvt_pk_bf16(v0[0], v0[1]); w.y = cvt_pk_bf16(v0[2], v0[3]); w.z = cvt_pk_bf16(v1[0], v1[1]); w.w = cvt_pk_bf16(v1[2], v1[3]);
                    *(u32x4*)(rowp + bj * HALF) = w; }
        }
    }
};
struct EpiGlu {
    static constexpr bool PERM = true, AFTER_DRAIN = false;
    bf16_t* U; bf16_t* ZW; const float* rowsq; const float* bias;
    __device__ __forceinline__ void operator()(const f32x4 (&acc)[2][2][4][2], const Unit& u, int wr, int wc, int fr, int fq) const {
        const int row0 = u.pm * BM + wr * 64 + fr;
        const float* bp = bias + (size_t)epi_cond(u.pm) * 4096 + u.pn * BM + wc * 32 + 8 * fq;
        const f32x4 ba0 = *(const f32x4*)bp, ba1 = *(const f32x4*)(bp + 4), bg0 = *(const f32x4*)(bp + HALF), bg1 = *(const f32x4*)(bp + HALF + 4);
        float rsv[2][4];
#pragma unroll
        for (int ai = 0; ai < 2; ++ai)
#pragma unroll
            for (int m = 0; m < 4; ++m) rsv[ai][m] = epi_rstd(rowsq, row0 + ai * HALF + m * 16);
        if (u.pn < 4) {
            const int col0 = u.pn * 128 + wc * 32 + 8 * fq;
#pragma unroll
            for (int ai = 0; ai < 2; ++ai)
#pragma unroll
                for (int m = 0; m < 4; ++m) { const int row = row0 + ai * HALF + m * 16; bf16_t* rowp = U + (size_t)row * 512 + col0; const float rs = rsv[ai][m];
                    const f32x4 a0 = acc[ai][0][m][0] * rs + ba0, a1 = acc[ai][0][m][1] * rs + ba1, g0 = acc[ai][1][m][0] * rs + bg0, g1 = acc[ai][1][m][1] * rs + bg1;
                    f32x4 v0, v1;
#pragma unroll
                    for (int j = 0; j < 4; ++j) {
                        v0[j] = a0[j] * __builtin_amdgcn_rcpf(1.0f + __expf(-g0[j]));
                        v1[j] = a1[j] * __builtin_amdgcn_rcpf(1.0f + __expf(-g1[j])); }
                    u32x4 w; w.x = cvt_pk_bf16(v0[0], v0[1]); w.y = cvt_pk_bf16(v0[2], v0[3]); w.z = cvt_pk_bf16(v1[0], v1[1]); w.w = cvt_pk_bf16(v1[2], v1[3]);
                    *(u32x4*)rowp = w; }
        } else {
            const int col0 = (u.pn - 4) * BM + wc * 32 + 8 * fq;
#pragma unroll
            for (int ai = 0; ai < 2; ++ai)
#pragma unroll
                for (int m = 0; m < 4; ++m) { const int row = row0 + ai * HALF + m * 16; bf16_t* rowp = ZW + (size_t)row * 512 + col0; const float rs = rsv[ai][m];
#pragma unroll
                    for (int bj = 0; bj < 2; ++bj) { const f32x4 v0 = acc[ai][bj][m][0] * rs + (bj ? bg0 : ba0), v1 = acc[ai][bj][m][1] * rs + (bj ? bg1 : ba1);
                        u32x4 w; w.x = cvt_pk_bf16(v0[0], v0[1]); w.y = cvt_pk_bf16(v0[2], v0[3]); w.z = cvt_pk_bf16(v1[0], v1[1]); w.w = cvt_pk_bf16(v1[2], v1[3]);
                        *(u32x4*)(rowp + bj * HALF) = w; } }
        }
    }
};
struct EpiResid {
    static constexpr bool PERM = false, AFTER_DRAIN = false;
    float* X; const float* gate_l;
    bf16_t* An; const float* gn; const float* scn_l; float* rowsq_n;
    float gscale;
    float* Pex; unsigned* cnt; unsigned target; int full_nt;
    __device__ __forceinline__ void operator()(f32x4 (&acc)[2][2][4][2], const Unit& u, int wr, int wc, int fr, int fq) const {
        typedef __attribute__((address_space(1))) f32x4 gf32x4; typedef __attribute__((address_space(1))) float gfloat;
        int sai = -1, sbj = -1;
        if (u.nt != full_nt) {
            const int st = (u.pm * 4 + u.pn) - 256, part = u.k0 / (u.nt * BK); const int tid = (wr * 4 + wc) * 64 + fq * 16 + fr;
            sai = part >> 1; sbj = part & 1;
            const __amdgpu_buffer_rsrc_t rs = __builtin_amdgcn_make_buffer_rsrc(Pex, 0, 64 * 4 * 4 * 8 * 512 * 16, 0x00020000);
#pragma unroll
            for (int ai = 0; ai < 2; ++ai)
#pragma unroll
                for (int bj = 0; bj < 2; ++bj) { if (ai == sai && bj == sbj) continue;
                    const unsigned off0 = (unsigned)(((((st * 4 + part) * 4 + ai * 2 + bj) * 8) * 512 + tid) * 16);
#pragma unroll
                    for (int m = 0; m < 4; ++m)
#pragma unroll
                        for (int n = 0; n < 2; ++n) __builtin_amdgcn_raw_buffer_store_b128(__builtin_bit_cast(u32x4, acc[ai][bj][m][n]), rs, off0 + (unsigned)((m * 2 + n) * 512 * 16), 0, 16); }
            asm volatile("s_waitcnt vmcnt(0)" ::: "memory"); __builtin_amdgcn_s_barrier(); asm volatile("" ::: "memory");
            if (tid == 0) { (void)__hip_atomic_fetch_add(cnt + 64 * st, 1u, __ATOMIC_RELAXED, __HIP_MEMORY_SCOPE_AGENT); unsigned sp = 0;
                while (__hip_atomic_load(cnt + 64 * st, __ATOMIC_RELAXED, __HIP_MEMORY_SCOPE_AGENT) < target) { __builtin_amdgcn_s_sleep(2); if (++sp > (1u << 22)) break; }
                __builtin_amdgcn_fence(__ATOMIC_ACQUIRE, "agent"); asm volatile("s_waitcnt vmcnt(0)" ::: "memory"); }
            asm volatile("s_waitcnt vmcnt(0) lgkmcnt(0)" ::: "memory"); __builtin_amdgcn_s_barrier(); asm volatile("" ::: "memory");
#pragma unroll
            for (int ai = 0; ai < 2; ++ai)
#pragma unroll
                for (int bj = 0; bj < 2; ++bj) { if (ai != sai || bj != sbj) continue;
#pragma unroll
                    for (int w = 1; w < 4; ++w) { const int wp = (part + w) & 3;
                        const gf32x4* p = (const gf32x4*)Pex + ((size_t)(((st * 4 + wp) * 4 + ai * 2 + bj) * 8)) * 512 + tid;
#pragma unroll
                        for (int m = 0; m < 4; ++m)
#pragma unroll
                            for (int n = 0; n < 2; ++n) acc[ai][bj][m][n] += p[(size_t)(m * 2 + n) * 512]; } }
        }
        const int cond = epi_cond(u.pm);
        const float* gate = gate_l + (size_t)cond * 6144; const float* scn = scn_l + (size_t)cond * 6144;
        const int col0 = u.pn * BM + wc * 32 + 4 * fq; const int rowt = u.pm * BM + wr * 64 + fr;
        float ssq[2][4];
#pragma unroll
        for (int ai = 0; ai < 2; ++ai)
#pragma unroll
            for (int m = 0; m < 4; ++m) ssq[ai][m] = 0.f;
        f32x4 xs[2][4], gvv[2], gmm[2];
#define ER_ACT(b_) (sbj < 0 || ((((b_) >> 2) == sbj) && (((b_) & 1) == sai)))
#define ER_LOAD(b_, q_) do { const int c_ = col0 + ((b_) >> 2) * HALF + (((b_) >> 1) & 1) * 16; \
        _Pragma("unroll") for (int m = 0; m < 4; ++m) xs[q_][m] = *(const gf32x4*)(X + (size_t)(rowt + ((b_) & 1) * HALF + m * 16) * 1024 + c_); \
        gvv[q_] = *(const f32x4*)(gate + c_) * gscale; gmm[q_] = An ? *(const f32x4*)(gn + c_) * (*(const f32x4*)(scn + c_) + 1.0f) : (f32x4){0.f, 0.f, 0.f, 0.f}; } while (0)
        if (ER_ACT(0)) ER_LOAD(0, 0);
#pragma unroll
        for (int b = 0; b < 8; ++b) {
            const int bj = b >> 2, n = (b >> 1) & 1, ai = b & 1, q = b & 1, c = col0 + bj * HALF + n * 16;
            if (b + 1 < 8) { if (ER_ACT(b + 1)) ER_LOAD(b + 1, q ^ 1); }
            if (!ER_ACT(b)) continue;
#pragma unroll
            for (int m = 0; m < 4; ++m) { const size_t off = (size_t)(rowt + ai * HALF + m * 16) * 1024 + c;
                const f32x4 x = xs[q][m] + gvv[q] * acc[ai][bj][m][n]; *(gf32x4*)(X + off) = x;
                if (An) { ssq[ai][m] += (x[0] * x[0] + x[1] * x[1]) + (x[2] * x[2] + x[3] * x[3]); const f32x4 h = x * gmm[q];
                    u32x2 w; w.x = cvt_pk_bf16(h[0], h[1]); w.y = cvt_pk_bf16(h[2], h[3]); *(u32x2*)(An + off) = w; } }
        }
#undef ER_ACT
#undef ER_LOAD
        if (An) {
            const int lane = fq * 16 + fr;
#pragma unroll
            for (int ai = 0; ai < 2; ++ai)
#pragma unroll
                for (int m = 0; m < 4; ++m) { if (sai >= 0 && ai != sai) continue; float s = ssq[ai][m];
                    s += __builtin_bit_cast(float, __builtin_amdgcn_ds_bpermute((lane ^ 16) << 2, __builtin_bit_cast(int, s)));
                    s += __builtin_bit_cast(float, __builtin_amdgcn_ds_bpermute((lane ^ 32) << 2, __builtin_bit_cast(int, s)));
                    if (fq == 0) (void)__hip_atomic_fetch_add((gfloat*)(rowsq_n + rowt + ai * HALF + m * 16), s, __ATOMIC_RELAXED, __HIP_MEMORY_SCOPE_AGENT); }
        }
    }
};
struct EpiQm {
    static constexpr bool PERM = false, AFTER_DRAIN = false;
    bf16_t* Qm; float qscale;
    __device__ __forceinline__ void operator()(const f32x4 (&acc)[2][2][4][2], const Unit& u, int wr, int wc, int fr, int fq) const {
        float invf[4];
#pragma unroll
        for (int j = 0; j < 4; ++j) invf[j] = exp2f(-(float)(4 * (fq & 1) + j) * (13.287712379549449f / 8.0f)) * 0.15915494309189535f;
#pragma unroll
        for (int bj = 0; bj < 2; ++bj) {
            const int cgp = u.pn * BM + bj * HALF + wc * 32;
            const bool is_rope = ((cgp >> 5) % 3) == 2;
#pragma unroll
            for (int ai = 0; ai < 2; ++ai)
#pragma unroll
                for (int m = 0; m < 4; ++m) {
                    const int r = u.pm * BM + ai * HALF + wr * 64 + m * 16 + fr;
                    f32x4 v0 = acc[ai][bj][m][0], v1 = acc[ai][bj][m][1];
                    if (is_rope && r >= 4096) {
                        const int t = (r - 4096) & 2047; const float pos = (float)((fq < 2) ? (t >> 6) : (t & 63));
#pragma unroll
                        for (int j = 0; j < 4; ++j) { const float rev = pos * invf[j]; const float c = __builtin_amdgcn_cosf(rev), s = __builtin_amdgcn_sinf(rev);
                            const float x1 = v0[j], x2 = v1[j]; v0[j] = x1 * c - x2 * s; v1[j] = x1 * s + x2 * c; }
                    }
                    v0 = v0 * qscale; v1 = v1 * qscale;
                    bf16_t* p = Qm + (size_t)r * 768 + cgp + 4 * fq;
                    u32x2 w0, w1; w0.x = cvt_pk_bf16(v0[0], v0[1]); w0.y = cvt_pk_bf16(v0[2], v0[3]); w1.x = cvt_pk_bf16(v1[0], v1[1]); w1.y = cvt_pk_bf16(v1[2], v1[3]);
                    *(u32x2*)p = w0; *(u32x2*)(p + 16) = w1;
                }
        }
    }
};

template <class Epi, class Sched, bool ALIGN_EPI = false, bool SP2 = false>
__device__ __forceinline__ void gemm_phase(PG8_LAS unsigned char* lds, const Gemm g, const Sched& S, const Epi& E, const int tid_in) {
    const int tid = tid_in, wid = __builtin_amdgcn_readfirstlane(tid >> 6), lane = tid & 63, wr = wid >> 2, wc = wid & 3, fr = lane & 15, fq = lane >> 4;
    const int K = g.K;
    unsigned voffA[2], voffB[2];
#pragma unroll
    for (int i = 0; i < 2; ++i) { int R, C; stage_rc(tid * 16 + i * 8192, R, C); const int Rb = Epi::PERM ? ((R & ~31) + perm32(R & 31)) : R;
        voffA[i] = (unsigned)(R * K + C) * 2u; voffB[i] = (unsigned)(Rb * K + C) * 2u; }
    const size_t kstep = (size_t)(BK * 2);
    const size_t hstep = (size_t)HALF * K * 2;
    const size_t tstep = 2 * hstep;
    const unsigned ldsw = (unsigned)wid * 1024u;
    const int aoff = lds_byte(wr * 64 + fr, fq * 8), boff = lds_byte(wc * 32 + fr, fq * 8);
#define PG8_SA(b, h) (((b) * 2 + (h)) * HTB)
#define PG8_SB(b, h) ((4 + (b) * 2 + (h)) * HTB)
#define PG8_STAGE(bufoff, gbase, voff) do { _Pragma("unroll") for (int _i = 0; _i < 2; ++_i) \
        __builtin_amdgcn_global_load_lds((const unsigned*)((const char*)(gbase) + (voff)[_i]), (PG8_LAS unsigned*)(lds + (bufoff) + ldsw + _i * 8192), 16, 0, 0); } while (0)
#define PG8_LDA(dst, b, h) do { _Pragma("unroll") for (int m = 0; m < 4; ++m) _Pragma("unroll") for (int k = 0; k < 2; ++k) dst[m][k] = *(const PG8_LAS bf16x8*)(lds + PG8_SA(b, h) + aoff + m * 2048 + k * 1024); } while (0)
#define PG8_LDB(dst, b, h) do { _Pragma("unroll") for (int n = 0; n < 2; ++n) _Pragma("unroll") for (int k = 0; k < 2; ++k) dst[n][k] = *(const PG8_LAS bf16x8*)(lds + PG8_SB(b, h) + boff + n * 2048 + k * 1024); } while (0)
#define PG8_MMA(ai, bj, At, Bt) do { __builtin_amdgcn_s_setprio(1); _Pragma("unroll") for (int m = 0; m < 4; ++m) _Pragma("unroll") for (int n = 0; n < 2; ++n) _Pragma("unroll") for (int k = 0; k < 2; ++k) \
        acc[ai][bj][m][n] = __builtin_amdgcn_mfma_f32_16x16x32_bf16(Bt[n][k], At[m][k], acc[ai][bj][m][n], 0, 0, 0); __builtin_amdgcn_s_setprio(0); } while (0)
#define PG8_WAIT_V(n) asm volatile("s_waitcnt vmcnt(" #n ")" ::: "memory")
#define PG8_WAIT_L(n) asm volatile("s_waitcnt lgkmcnt(" #n ")" ::: "memory")
#define PG8_BAR __builtin_amdgcn_s_barrier()
#define PG8_SCHED __builtin_amdgcn_sched_barrier(0)
    Unit cur, nxt; int ui = 0;
    if (!S.next(0, cur)) return;
    f32x4 acc[2][2][4][2];
#pragma unroll
    for (int a = 0; a < 2; ++a)
#pragma unroll
        for (int b = 0; b < 2; ++b)
#pragma unroll
            for (int m = 0; m < 4; ++m)
#pragma unroll
                for (int n = 0; n < 2; ++n) acc[a][b][m][n] = (f32x4){0.f, 0.f, 0.f, 0.f};
    bf16x8 At[4][2], B0[2][2], B1[2][2];
    const char* cA = (const char*)g.A + (size_t)cur.pm * tstep + (size_t)cur.k0 * 2; const char* cB = (const char*)g.Bt + (size_t)cur.pn * tstep + (size_t)cur.k0 * 2;
    S.a_ready(cur);
    if constexpr (SP2) {
        PG8_STAGE(PG8_SB(0, 0), cB, voffB); PG8_STAGE(PG8_SB(0, 1), cB + hstep, voffB); PG8_STAGE(PG8_SA(0, 0), cA, voffA); PG8_STAGE(PG8_SA(0, 1), cA + hstep, voffA);
        if (wr == 1) PG8_BAR;
        PG8_WAIT_V(2); PG8_BAR;
        PG8_STAGE(PG8_SB(1, 0), cB + kstep, voffB); PG8_STAGE(PG8_SA(1, 0), cA + kstep, voffA); PG8_STAGE(PG8_SB(1, 1), cB + hstep + kstep, voffB);
        PG8_WAIT_V(6); PG8_BAR;
    } else {
        PG8_STAGE(PG8_SB(0, 0), cB, voffB); PG8_STAGE(PG8_SA(0, 0), cA, voffA); PG8_STAGE(PG8_SB(0, 1), cB + hstep, voffB); PG8_STAGE(PG8_SA(0, 1), cA + hstep, voffA);
        if (wr == 1) PG8_BAR;
        PG8_WAIT_V(4); PG8_BAR;
        PG8_STAGE(PG8_SB(1, 0), cB + kstep, voffB); PG8_STAGE(PG8_SA(1, 0), cA + kstep, voffA); PG8_STAGE(PG8_SB(1, 1), cB + hstep + kstep, voffB);
        PG8_WAIT_V(6); PG8_BAR;
    }
    for (;;) {
        const bool has_next = S.next(ui + 1, nxt);
        const char* nA = has_next ? (const char*)g.A + (size_t)nxt.pm * tstep + (size_t)nxt.k0 * 2 : cA; const char* nB = has_next ? (const char*)g.Bt + (size_t)nxt.pn * tstep + (size_t)nxt.k0 * 2 : cB;
        const int nt = cur.nt;
        for (int t = 0; t < nt; t += 2) {
            const bool last = (t == nt - 2);
            const char* a1 = cA + (size_t)(t + 1) * kstep;
            const char* a2 = last ? nA : cA + (size_t)(t + 2) * kstep; const char* b2 = last ? nB : cB + (size_t)(t + 2) * kstep;
            const char* a3 = a2 + kstep; const char* b3 = b2 + kstep;
            if (last && has_next) S.a_ready(nxt);
            if constexpr (SP2) {
            PG8_LDB(B0, 0, 0); PG8_LDB(B1, 0, 1); PG8_SCHED; PG8_LDA(At, 0, 0); PG8_STAGE(PG8_SA(1, 1), a1 + hstep, voffA);
            PG8_WAIT_V(8); PG8_WAIT_L(0); PG8_BAR; PG8_MMA(0, 0, At, B0); PG8_MMA(0, 1, At, B1); PG8_BAR; PG8_SCHED;
            PG8_LDA(At, 0, 1); PG8_STAGE(PG8_SB(0, 0), b2, voffB); PG8_STAGE(PG8_SB(0, 1), b2 + hstep, voffB); PG8_STAGE(PG8_SA(0, 0), a2, voffA);
            PG8_WAIT_V(8); PG8_WAIT_L(0); PG8_BAR; PG8_MMA(1, 0, At, B0); PG8_MMA(1, 1, At, B1); PG8_BAR; PG8_SCHED;
            PG8_LDB(B0, 1, 0); PG8_LDB(B1, 1, 1); PG8_SCHED; PG8_LDA(At, 1, 0); PG8_STAGE(PG8_SA(0, 1), a2 + hstep, voffA);
            PG8_WAIT_V(8); PG8_WAIT_L(0); PG8_BAR; PG8_MMA(0, 0, At, B0); PG8_MMA(0, 1, At, B1); PG8_BAR; PG8_SCHED;
            PG8_LDA(At, 1, 1); PG8_STAGE(PG8_SB(1, 0), b3, voffB); PG8_STAGE(PG8_SB(1, 1), b3 + hstep, voffB); PG8_STAGE(PG8_SA(1, 0), a3, voffA);
            PG8_WAIT_V(8); PG8_WAIT_L(0); PG8_BAR; PG8_MMA(1, 0, At, B0); PG8_MMA(1, 1, At, B1); PG8_BAR; PG8_SCHED;
            } else {
            PG8_LDB(B0, 0, 0); PG8_SCHED; PG8_LDA(At, 0, 0); PG8_STAGE(PG8_SA(1, 1), a1 + hstep, voffA);
            PG8_WAIT_L(8); PG8_BAR; PG8_WAIT_L(0); PG8_MMA(0, 0, At, B0); PG8_BAR; PG8_SCHED;
            PG8_LDB(B1, 0, 1); PG8_STAGE(PG8_SB(0, 0), b2, voffB);
            PG8_BAR; PG8_WAIT_L(0); PG8_MMA(0, 1, At, B1); PG8_BAR;
            PG8_LDA(At, 0, 1); PG8_STAGE(PG8_SA(0, 0), a2, voffA);
            PG8_BAR; PG8_WAIT_L(0); PG8_MMA(1, 0, At, B0); PG8_BAR; PG8_SCHED;
            PG8_STAGE(PG8_SB(0, 1), b2 + hstep, voffB);
            PG8_WAIT_V(6); PG8_BAR; PG8_MMA(1, 1, At, B1); PG8_BAR;
            PG8_LDB(B0, 1, 0); PG8_SCHED; PG8_LDA(At, 1, 0); PG8_STAGE(PG8_SA(0, 1), a2 + hstep, voffA);
            PG8_WAIT_L(8); PG8_BAR; PG8_WAIT_L(0); PG8_MMA(0, 0, At, B0); PG8_BAR; PG8_SCHED;
            PG8_LDB(B1, 1, 1); PG8_STAGE(PG8_SB(1, 0), b3, voffB);
            PG8_BAR; PG8_WAIT_L(0); PG8_MMA(0, 1, At, B1); PG8_BAR;
            PG8_LDA(At, 1, 1); PG8_STAGE(PG8_SA(1, 0), a3, voffA);
            PG8_BAR; PG8_WAIT_L(0); PG8_MMA(1, 0, At, B0); PG8_BAR; PG8_SCHED;
            PG8_STAGE(PG8_SB(1, 1), b3 + hstep, voffB);
            PG8_WAIT_V(6); PG8_BAR; PG8_MMA(1, 1, At, B1); PG8_BAR;
            }
        }
        if constexpr (ALIGN_EPI) { if (wr == 0) PG8_BAR; }
        if constexpr (!Epi::AFTER_DRAIN) { E(acc, cur, wr, wc, fr, fq); S.done(cur); }
        if (!has_next) break;
#pragma unroll
        for (int a = 0; a < 2; ++a)
#pragma unroll
            for (int b = 0; b < 2; ++b)
#pragma unroll
                for (int m = 0; m < 4; ++m)
#pragma unroll
                    for (int n = 0; n < 2; ++n) acc[a][b][m][n] = (f32x4){0.f, 0.f, 0.f, 0.f};
        cur = nxt; cA = nA; cB = nB; ++ui;
        if constexpr (ALIGN_EPI) { if (wr == 1) PG8_BAR; }
    }
    PG8_WAIT_V(0);
    if constexpr (!ALIGN_EPI) { if (wr == 0) PG8_BAR; }
    PG8_BAR;
    if constexpr (Epi::AFTER_DRAIN) { E.fused(acc, cur, wr, wc, fr, fq, lds, wid, lane); S.done(cur); }
#undef PG8_SA
#undef PG8_SB
#undef PG8_STAGE
#undef PG8_LDA
#undef PG8_LDB
#undef PG8_MMA
#undef PG8_WAIT_V
#undef PG8_WAIT_L
#undef PG8_BAR
#undef PG8_SCHED
}
}

#define LAS __attribute__((address_space(3)))
#define GAS __attribute__((address_space(1)))
typedef unsigned short bf16;
typedef float f32x4 __attribute__((ext_vector_type(4)));
typedef float f32x16 __attribute__((ext_vector_type(16)));
typedef short bf16x8 __attribute__((ext_vector_type(8)));
typedef short s16x4 __attribute__((ext_vector_type(4)));
typedef unsigned u32x4 __attribute__((ext_vector_type(4)));
typedef unsigned u32x2 __attribute__((ext_vector_type(2)));

constexpr int NWAVES = 8, NTHREADS = 512;
constexpr int DM = 1024, NCTX = 4096, NLAT = 16384, T = NCTX + NLAT, TR = T + 2048;
constexpr int DEPTH = 4, FF = 4096;
constexpr int AIN = 1120, AINP = 1280;
constexpr float EPS = 1e-6f;
constexpr float LOG2E = 1.4426950408889634f;
constexpr float QS_A = 0.125f * LOG2E;
constexpr float QS_M = 0.10206207261596575f * LOG2E;
constexpr float NEGBIG = -1.0e30f;

constexpr size_t OUT_Y = 0, OUT_K = (size_t)T * DM, OUT_V = OUT_K + 1048576, OUT_CKV = OUT_V + 1048576, OUT_KR = OUT_CKV + 1048576, OUT_END = OUT_KR + 262144;

constexpr size_t MiB = 1u << 20;
constexpr size_t WS_MOD = 1 * MiB;
constexpr size_t WS_WIN = 2 * MiB;
constexpr size_t WS_WQB = 7 * MiB;
constexpr size_t WS_WKVB = 8 * MiB;
constexpr size_t WS_WOUT = 9 * MiB;
constexpr size_t WS_CIN = 13 * MiB;
constexpr size_t WS_COUT = 19 * MiB;
constexpr size_t WS_W1 = 23 * MiB;
constexpr size_t WS_W2 = 55 * MiB;
constexpr size_t WS_ROWSQ = 64 * 1024;
constexpr size_t WS_X = 88 * MiB;
constexpr size_t WS_S = 168 * MiB;
constexpr size_t WS_QA = WS_S + 0 * MiB;
constexpr size_t WS_KA = WS_S + 20 * MiB;
constexpr size_t WS_VA = WS_S + 26 * MiB;
constexpr size_t WS_KRR = WS_S + 32 * MiB;
constexpr size_t WS_PROJ = WS_S + 34 * MiB;
constexpr size_t WS_QM = WS_S + 34 * MiB;
constexpr size_t WS_KV = WS_S + 64 * MiB;
constexpr size_t WS_O = WS_S + 110 * MiB;
constexpr size_t WS_CQN = WS_S + 150 * MiB;
constexpr size_t WS_CKVN = WS_S + 144 * MiB;
constexpr size_t WS_HID = WS_S;
constexpr size_t WS_H = 328 * MiB;
constexpr size_t WS_BIAS = 368 * MiB;
constexpr size_t WS_END = 370 * MiB;

constexpr int LDS_BYTES = 147456;

struct Args {
    const float* x_prompt; const float* x_sample; const float* cache_win_k; const float* cache_win_v; const float* cache_mla_ckv; const float* cache_mla_krope;
    const float* c; const float* c_ctx; const float* w_mod; const float* b_mod; const float* norm_g; const float* attn_w_in; const float* attn_sink;
    const float* mla_q_norm; const float* mla_kv_norm; const float* mla_w_qb; const float* mla_w_kvb; const float* attn_w_out; const float* conv_w_in;
    const float* conv_dw; const float* conv_dw_b; const float* conv_ln_g; const float* conv_ln_b; const float* pool_w; const float* pool_scale;
    const float* conv_w_out; const float* mlp_w1; const float* mlp_w2; const float* final_g;
    float* out; unsigned char* ws;
    int ph_lo, ph_hi;
};

__device__ __forceinline__ unsigned f2bf(float f) { unsigned u = __builtin_bit_cast(unsigned, f); return (u + 0x7fffu + ((u >> 16) & 1u)) >> 16; }
__device__ __forceinline__ unsigned pk2(float lo, float hi) { return f2bf(lo) | (f2bf(hi) << 16); }
__device__ __forceinline__ float bf2f(unsigned short b) { return __builtin_bit_cast(float, (unsigned)b << 16); }
__device__ __forceinline__ float shfl_xor_l(float v, int lane, int o) { return __builtin_bit_cast(float, __builtin_amdgcn_ds_bpermute((lane ^ o) << 2, __builtin_bit_cast(int, v))); }
template <int CTRL> __device__ __forceinline__ float dpp_get(float v) { return __builtin_bit_cast(float, __builtin_amdgcn_update_dpp(0, __builtin_bit_cast(int, v), CTRL, 0xF, 0xF, false)); }
__device__ __forceinline__ float wave_sum(float v, int lane) {
    (void)lane;
    v += dpp_get<0xB1>(v);
    v += dpp_get<0x4E>(v);
    v += dpp_get<0x141>(v);
    v += dpp_get<0x140>(v);
    const int b = __builtin_bit_cast(int, v);
    return (__builtin_bit_cast(float, __builtin_amdgcn_readlane(b, 0)) + __builtin_bit_cast(float, __builtin_amdgcn_readlane(b, 16)))
         + (__builtin_bit_cast(float, __builtin_amdgcn_readlane(b, 32)) + __builtin_bit_cast(float, __builtin_amdgcn_readlane(b, 48)));
}
__device__ __forceinline__ void unpack8(const u32x4 w, float (&f)[8]) {
    f[0] = __builtin_bit_cast(float, w.x << 16); f[1] = __builtin_bit_cast(float, w.x & 0xffff0000u);
    f[2] = __builtin_bit_cast(float, w.y << 16); f[3] = __builtin_bit_cast(float, w.y & 0xffff0000u);
    f[4] = __builtin_bit_cast(float, w.z << 16); f[5] = __builtin_bit_cast(float, w.z & 0xffff0000u);
    f[6] = __builtin_bit_cast(float, w.w << 16); f[7] = __builtin_bit_cast(float, w.w & 0xffff0000u);
}
__device__ __forceinline__ u32x4 pack8(const float (&f)[8]) { u32x4 w; w.x = pk2(f[0], f[1]); w.y = pk2(f[2], f[3]); w.z = pk2(f[4], f[5]); w.w = pk2(f[6], f[7]); return w; }
__device__ __forceinline__ int cond_of_row(int r) { return r < NCTX ? 0 : 1 + ((r - NCTX) >> 11); }

__device__ __forceinline__ void transpose_item(const float* W, int N, bf16* WT, int dpitch, int k0, int n0, int drow0, LAS float* scr, int lane) {
    float tv[32];
#pragma unroll
    for (int i = 0; i < 32; ++i) tv[i] = ((const GAS float*)W)[(size_t)(k0 + 2 * i + (lane >> 5)) * N + n0 + (lane & 31)];
#pragma unroll
    for (int i = 0; i < 32; ++i) scr[(2 * i + (lane >> 5)) * 33 + (lane & 31)] = tv[i];
    asm volatile("s_waitcnt lgkmcnt(0)" ::: "memory");
    const int c = lane & 7;
#pragma unroll
    for (int j = 0; j < 4; ++j) { const int n = (lane >> 3) + 8 * j; const LAS float* s = scr + (8 * c) * 33 + n;
        u32x4 o; o.x = pk2(s[0 * 33], s[1 * 33]); o.y = pk2(s[2 * 33], s[3 * 33]); o.z = pk2(s[4 * 33], s[5 * 33]); o.w = pk2(s[6 * 33], s[7 * 33]);
        *(u32x4*)(WT + (size_t)(drow0 + n) * dpitch + k0 + 8 * c) = o; }
    asm volatile("s_waitcnt lgkmcnt(0)" ::: "memory");
}

__device__ __forceinline__ void p0_transposes(const Args& a, LAS unsigned char* lds, int gw, int NGW, int wave, int lane) {
    LAS float* scr = (LAS float*)(lds + wave * 16384);
    unsigned char* ws = a.ws;
    constexpr int I_WIN = 16 * 35, I_QB = 3 * 24, I_KVB = 2 * 32, I_SQ = 16 * 32, I_W1 = 16 * 128, I_W2 = 64 * 32;
    constexpr int NITEMS = 2 * (I_WIN + I_QB + I_KVB + I_SQ + I_SQ + I_SQ) + 4 * (I_W1 + I_W2);
    for (int it = gw; it < NITEMS; it += NGW) {
        int r = it;
        if (r < 4 * I_W1) { const int l = r / I_W1; r %= I_W1; const int kb = r / 128, nb = r % 128;
            transpose_item(a.mlp_w1 + (size_t)l * DM * FF, FF, (bf16*)(ws + WS_W1) + (size_t)l * FF * DM, DM, 64 * kb, 32 * nb, 32 * nb, scr, lane); continue; } r -= 4 * I_W1;
        if (r < 4 * I_W2) { const int l = r / I_W2; r %= I_W2; const int kb = r / 32, nb = r % 32;
            transpose_item(a.mlp_w2 + (size_t)l * FF * DM, DM, (bf16*)(ws + WS_W2) + (size_t)l * DM * FF, FF, 64 * kb, 32 * nb, 32 * nb, scr, lane); continue; } r -= 4 * I_W2;
        if (r < 2 * I_WIN) { const int l = r / I_WIN; r %= I_WIN; const int kb = r / 35, nb = r % 35;
            transpose_item(a.attn_w_in + (size_t)l * DM * AIN, AIN, (bf16*)(ws + WS_WIN) + (size_t)l * AINP * DM, DM, 64 * kb, 32 * nb, 32 * nb, scr, lane); continue; } r -= 2 * I_WIN;
        if (r < 2 * I_QB) { const int l = r / I_QB; r %= I_QB; const int kb = r / 24, nb = r % 24;
            transpose_item(a.mla_w_qb + (size_t)l * 192 * 768, 768, (bf16*)(ws + WS_WQB) + (size_t)l * 768 * 256, 256, 64 * kb, 32 * nb, 32 * nb, scr, lane); continue; } r -= 2 * I_QB;
        if (r < 2 * I_KVB) { const int l = r / I_KVB; r %= I_KVB; const int kb = r / 32, nb = r % 32;
            transpose_item(a.mla_w_kvb + (size_t)l * 128 * 1024, 1024, (bf16*)(ws + WS_WKVB) + (size_t)l * 1024 * 128, 128, 64 * kb, 32 * nb, 32 * nb, scr, lane); continue; } r -= 2 * I_KVB;
        if (r < 2 * I_SQ) { const int l = r / I_SQ; r %= I_SQ; const int kb = r / 32, nb = r % 32;
            transpose_item(a.attn_w_out + (size_t)l * DM * DM, DM, (bf16*)(ws + WS_WOUT) + (size_t)l * DM * DM, DM, 64 * kb, 32 * nb, 32 * nb, scr, lane); continue; } r -= 2 * I_SQ;
        if (r < 2 * I_SQ) { const int l = r / I_SQ; r %= I_SQ; const int kb = r / 32, nb = r % 32;
            transpose_item(a.conv_w_out + (size_t)l * DM * DM, DM, (bf16*)(ws + WS_COUT) + (size_t)l * DM * DM, DM, 64 * kb, 32 * nb, 32 * nb, scr, lane); continue; } r -= 2 * I_SQ;
        { const int l = r / I_SQ; r %= I_SQ; const int kb = r / 32, nb = r % 32; const int n0 = 32 * nb;
            const int drow = n0 < 512 ? 256 * (n0 >> 7) + (n0 & 127) : 256 * ((n0 - 512) >> 7) + 128 + ((n0 - 512) & 127);
            transpose_item(a.conv_w_in + (size_t)l * DM * 1536, 1536, (bf16*)(ws + WS_CIN) + (size_t)l * 1536 * DM, DM, 64 * kb, n0, drow, scr, lane); }
    }
    for (int i = gw * 64 + lane; i < 7 * T / 4; i += NGW * 64) *((f32x4*)(ws + WS_ROWSQ) + T / 4 + i) = (f32x4){0.f, 0.f, 0.f, 0.f};
    for (int i = gw * 64 + lane; i < 2 * 768 * 8; i += NGW * 64) { const int row = i >> 3, ch = i & 7;
        *(u32x4*)((bf16*)(ws + WS_WQB) + (size_t)row * 256 + 192 + ch * 8) = (u32x4){0u, 0u, 0u, 0u}; }
}

__device__ __forceinline__ void p0_fold(const Args& a, LAS unsigned char* lds, int bid, int G, int tid) {
    LAS float* Wl = (LAS float*)lds;
    LAS float* Pl = (LAS float*)(lds + 16384);
    for (int u = bid; u < 256; u += G) {
        const int j = u >> 7, g = (u >> 5) & 3, kc = u & 31, k0 = kc * 32;
        const float* Wsrc = a.conv_w_in + (size_t)j * DM * 1536 + 1024 + g * 128;
        const float* Psrc = a.pool_w + (size_t)(j * 4 + g) * 128 * 128;
        for (int i = tid; i < 32 * 128; i += NTHREADS) Wl[i] = Wsrc[(size_t)(k0 + (i >> 7)) * 1536 + (i & 127)];
        for (int i = tid; i < 128 * 128; i += NTHREADS) Pl[i] = Psrc[i];
        __syncthreads();
        const int d = tid & 127, kq = tid >> 7;
        float acc[8];
#pragma unroll
        for (int i = 0; i < 8; ++i) acc[i] = 0.f;
        for (int c = 0; c < 128; ++c) { const float p = Pl[c * 128 + d];
#pragma unroll
            for (int i = 0; i < 8; ++i) acc[i] += Wl[(kq * 8 + i) * 128 + c] * p; }
        const float sc = a.pool_scale[j * 512 + g * 128 + d];
#pragma unroll
        for (int i = 0; i < 8; ++i) acc[i] *= sc;
        *(u32x4*)((bf16*)(a.ws + WS_CIN) + (size_t)j * 1536 * DM + (size_t)(1024 + g * 128 + d) * DM + k0 + kq * 8) = pack8(acc);
        __syncthreads();
    }
}

__device__ __forceinline__ void p0_adaln(const Args& a, LAS unsigned char* lds, int bid, int G, int tid) {
    LAS float* sc = (LAS float*)lds;
    LAS float* red = (LAS float*)(lds + 40960);
    for (int i = tid; i < 9 * 1024; i += NTHREADS) { const int cnd = i >> 10, k = i & 1023; const float v = cnd == 0 ? a.c_ctx[k] : a.c[(cnd - 1) * 1024 + k];
        sc[k * 9 + cnd] = v / (1.0f + __expf(-v)); }
    __syncthreads();
    const int col = tid & 63, kg = tid >> 6;
    for (int u = bid; u < 4 * 96; u += G) {
        const int l = u / 96, n0 = (u % 96) * 64;
        const float* w = a.w_mod + (size_t)l * DM * 6144 + n0 + col;
        float acc[9];
#pragma unroll
        for (int c = 0; c < 9; ++c) acc[c] = 0.f;
        for (int k = kg * 128; k < kg * 128 + 128; k += 32) {
            float wv[32];
#pragma unroll
            for (int i = 0; i < 32; ++i) wv[i] = ((const GAS float*)w)[(size_t)(k + i) * 6144];
#pragma unroll
            for (int i = 0; i < 32; ++i)
#pragma unroll
                for (int c = 0; c < 9; ++c) acc[c] += sc[(k + i) * 9 + c] * wv[i];
        }
#pragma unroll
        for (int c = 0; c < 9; ++c) red[(kg * 9 + c) * 64 + col] = acc[c];
        __syncthreads();
        for (int i = tid; i < 9 * 64; i += NTHREADS) { const int c = i >> 6, cc = i & 63; float s = a.b_mod[l * 6144 + n0 + cc];
#pragma unroll
            for (int q = 0; q < 8; ++q) s += red[(q * 9 + c) * 64 + cc];
            ((float*)(a.ws + WS_MOD))[(size_t)(l * 9 + c) * 6144 + n0 + cc] = s; }
        __syncthreads();
    }
}

__device__ __forceinline__ void prep_pass(const Args& a, int gw, int NGW, int lane) {
    const float* MOD = (const float*)(a.ws + WS_MOD);
    const float* g = a.norm_g;
    float* X = (float*)(a.ws + WS_X); bf16* H = (bf16*)(a.ws + WS_H); float* RSQ = (float*)(a.ws + WS_ROWSQ);
    f32x4 v[4], vn[4], sv[4], svn[4], ggv[4];
#pragma unroll
    for (int j = 0; j < 4; ++j) { ggv[j] = ((const GAS f32x4*)g + lane)[64 * j]; sv[j] = ggv[j]; svn[j] = ggv[j]; vn[j] = ggv[j]; v[j] = ggv[j]; }
#define PREP_LOAD(dst, sdst, r_) do { const float* src_ = (r_) < NCTX ? a.x_prompt + (size_t)(r_) * DM : a.x_sample + (size_t)((r_) - NCTX) * DM; \
        const float* sc_ = MOD + (size_t)cond_of_row(r_) * 6144 + 1024; \
        _Pragma("unroll") for (int j = 0; j < 4; ++j) { dst[j] = ((const GAS f32x4*)src_ + lane)[64 * j]; sdst[j] = ((const GAS f32x4*)sc_ + lane)[64 * j]; } } while (0)
    if (gw < T) PREP_LOAD(v, sv, gw);
    for (int r = gw; r < T; r += NGW) {
        if (r + NGW < T) PREP_LOAD(vn, svn, r + NGW);
        float s = 0.f;
#pragma unroll
        for (int j = 0; j < 4; ++j) s += (v[j].x * v[j].x + v[j].y * v[j].y) + (v[j].z * v[j].z + v[j].w * v[j].w);
        s = wave_sum(s, lane);
        if (lane == 0) RSQ[r] = s;
        GAS unsigned long long* o8 = (GAS unsigned long long*)(H + (size_t)r * DM) + lane; GAS f32x4* xo = (GAS f32x4*)(X + (size_t)r * DM) + lane;
#pragma unroll
        for (int j = 0; j < 4; ++j) { const f32x4 h = v[j] * ggv[j] * (sv[j] + 1.0f);
            o8[64 * j] = (unsigned long long)pk2(h.x, h.y) | ((unsigned long long)pk2(h.z, h.w) << 32); __builtin_nontemporal_store(v[j], (f32x4*)(xo + 64 * j)); }
#pragma unroll
        for (int j = 0; j < 4; ++j) { v[j] = vn[j]; sv[j] = svn[j]; }
    }
#undef PREP_LOAD
    constexpr int NB4 = (2 * 1280 + 2 * 1536 + 4 * 4096) / 4;
    for (int it = gw; it < NB4; it += NGW) {
        int r = it * 4, s, n; const bf16* wt;
        if (r < 4 * 4096) { const int l = r >> 12; n = r & 4095; s = 2 * l + 1; wt = (const bf16*)(a.ws + WS_W1) + (size_t)l * FF * DM; }
        else { r -= 4 * 4096;
            if (r < 2 * 1280) { const int li = r / 1280; n = r % 1280; s = 4 * li; wt = (const bf16*)(a.ws + WS_WIN) + (size_t)li * AINP * DM; }
            else { r -= 2 * 1280; const int lj = r / 1536; n = r % 1536; s = 4 * lj + 2; wt = (const bf16*)(a.ws + WS_CIN) + (size_t)lj * 1536 * DM; } }
        u32x4 wr0[4], wr1[4];
#pragma unroll
        for (int q = 0; q < 4; ++q) { wr0[q] = *(const GAS u32x4*)(wt + (size_t)(n + q) * DM + 16 * lane); wr1[q] = *(const GAS u32x4*)(wt + (size_t)(n + q) * DM + 16 * lane + 8); }
        float w[4][16];
#pragma unroll
        for (int q = 0; q < 4; ++q) { float t0[8], t1[8]; unpack8(wr0[q], t0); unpack8(wr1[q], t1);
#pragma unroll
            for (int e = 0; e < 8; ++e) { w[q][e] = t0[e]; w[q][8 + e] = t1[e]; } }
        const float* shb = MOD + (size_t)(s >> 1) * 9 * 6144 + ((s & 1) ? 3 : 0) * 1024 + 16 * lane;
        f32x4 outv = (f32x4){0.f, 0.f, 0.f, 0.f};
#pragma unroll
        for (int c = 0; c < 9; ++c) { const f32x4* sp = (const f32x4*)(shb + (size_t)c * 6144); const f32x4 s0 = sp[0], s1 = sp[1], s2 = sp[2], s3 = sp[3];
#pragma unroll
            for (int q = 0; q < 4; ++q) {
                float d = (s0.x * w[q][0] + s0.y * w[q][1] + s0.z * w[q][2] + s0.w * w[q][3]) + (s1.x * w[q][4] + s1.y * w[q][5] + s1.z * w[q][6] + s1.w * w[q][7])
                        + (s2.x * w[q][8] + s2.y * w[q][9] + s2.z * w[q][10] + s2.w * w[q][11]) + (s3.x * w[q][12] + s3.y * w[q][13] + s3.z * w[q][14] + s3.w * w[q][15]);
                d = wave_sum(d, lane); if (lane == c) outv[q] = d; } }
        if (lane < 9) *(f32x4*)((float*)(a.ws + WS_BIAS) + (size_t)(s * 9 + lane) * 4096 + n) = outv;
    }
}
__device__ __forceinline__ void final_norm(const Args& a, const float* P, int gw, int NGW, int lane) {
    const float* X = (const float*)(a.ws + WS_X); (void)P;
    f32x4 v[4], vn[4];
    f32x4 fgv[4];
#pragma unroll
    for (int j = 0; j < 4; ++j) fgv[j] = ((const GAS f32x4*)a.final_g + lane)[64 * j];
#define FN_LOAD(dst, r_) do { _Pragma("unroll") for (int j = 0; j < 4; ++j) dst[j] = ((const GAS f32x4*)(X + (size_t)(r_) * DM) + lane)[64 * j]; } while (0)
    if (gw < T) FN_LOAD(v, gw);
    for (int r = gw; r < T; r += NGW) {
        if (r + NGW < T) FN_LOAD(vn, r + NGW);
        float s = 0.f;
#pragma unroll
        for (int j = 0; j < 4; ++j) s += (v[j].x * v[j].x + v[j].y * v[j].y) + (v[j].z * v[j].z + v[j].w * v[j].w);
        const float rstd = 1.0f / sqrtf(wave_sum(s, lane) * (1.0f / DM) + EPS);
        GAS f32x4* o = (GAS f32x4*)(a.out + OUT_Y + (size_t)r * DM) + lane;
#pragma unroll
        for (int j = 0; j < 4; ++j) __builtin_nontemporal_store(v[j] * rstd * fgv[j], (f32x4*)(o + 64 * j));
#pragma unroll
        for (int j = 0; j < 4; ++j) v[j] = vn[j];
    }
#undef FN_LOAD
}

__device__ __forceinline__ void rope8(float (&x1)[8], float (&x2)[8], float pos, int j0, float quarter_inv) {
#pragma unroll
    for (int e = 0; e < 8; ++e) { const float rev = pos * exp2f(-(float)(j0 + e) * 13.287712379549449f * quarter_inv) * 0.15915494309189535f;
        const float c = __builtin_amdgcn_cosf(rev), s = __builtin_amdgcn_sinf(rev); const float a = x1[e], b = x2[e]; x1[e] = a * c - b * s; x2[e] = a * s + b * c; }
}
__device__ __forceinline__ void store8f(float* p, const float (&f)[8]) { *(f32x4*)p = (f32x4){f[0], f[1], f[2], f[3]}; *(f32x4*)(p + 4) = (f32x4){f[4], f[5], f[6], f[7]}; }
__device__ __forceinline__ void post_pass(const Args& a, int li, int gw, int NGW, int lane) {
    unsigned char* ws = a.ws;
    const bf16* PROJ = (const bf16*)(ws + WS_PROJ); bf16* Qa = (bf16*)(ws + WS_QA); bf16* Ka = (bf16*)(ws + WS_KA); bf16* Va = (bf16*)(ws + WS_VA);
    bf16* CQN = (bf16*)(ws + WS_CQN); bf16* CKVN = (bf16*)(ws + WS_CKVN); bf16* KRR = (bf16*)(ws + WS_KRR);
    int oa0 = -1, oa1 = -1, on = -1;
    if (lane < 40) { oa0 = (lane < 32 ? 0 : 512) + ((lane < 32 ? lane : lane - 32) >> 2) * 64 + (lane & 3) * 8; oa1 = oa0 + 32; }
    else if (lane < 56) oa0 = 640 + (lane - 40) * 8;
    else if (lane < 58) { oa0 = 1088 + (lane - 56) * 8; oa1 = oa0 + 16; }
    if (lane < 24) on = 768 + lane * 8; else if (lane < 40) on = 960 + (lane - 24) * 8;
    float gnv[8];
#pragma unroll
    for (int e = 0; e < 8; ++e) gnv[e] = lane < 24 ? a.mla_q_norm[li * 192 + lane * 8 + e] : (lane < 40 ? a.mla_kv_norm[li * 128 + (lane - 24) * 8 + e] : 0.f);
    u32x4 ua0 = (u32x4){0u, 0u, 0u, 0u}, ua1 = ua0, un = ua0, na0 = ua0, na1 = ua0, nn = ua0;
#define PP_LOAD(d0_, d1_, dn_, r_) do { const GAS bf16* p_ = (const GAS bf16*)PROJ + (size_t)(r_) * AINP; \
        if (oa0 >= 0) d0_ = *(const GAS u32x4*)(p_ + oa0); if (oa1 >= 0) d1_ = *(const GAS u32x4*)(p_ + oa1); if (on >= 0) dn_ = *(const GAS u32x4*)(p_ + on); } while (0)
    if (gw < T) PP_LOAD(ua0, ua1, un, gw);
    for (int r = gw; r < TR; r += NGW) {
        if (r + NGW < T) PP_LOAD(na0, na1, nn, r + NGW);
        if (r >= T) {
            const int idx = r - T, b = idx >> 8, p = idx & 255; const size_t src = (size_t)((b * 2 + li) * 256 + p);
            const float* ck = a.cache_win_k + src * 128 + 2 * lane; const float* cv = a.cache_win_v + src * 128 + 2 * lane; const float* cc = a.cache_mla_ckv + src * 128 + 2 * lane;
            *(unsigned*)(Ka + (size_t)r * 128 + 2 * lane) = pk2(ck[0], ck[1]);
            *(unsigned*)(Va + (size_t)r * 128 + 2 * lane) = pk2(cv[0], cv[1]);
            *(unsigned*)(CKVN + (size_t)r * 128 + 2 * lane) = pk2(cc[0], cc[1]);
            if (lane < 16) { const float* cr = a.cache_mla_krope + src * 32 + 2 * lane; *(unsigned*)(KRR + (size_t)r * 32 + 2 * lane) = pk2(cr[0], cr[1]); }
            continue;
        }
        const bf16* p = PROJ + (size_t)r * AINP;
        const bool lat = r >= NCTX; const int t = lat ? ((r - NCTX) & 2047) : (r & 255);
        const float prow = (float)(t >> 6), pcol = (float)(t & 63);
        const size_t obase = (size_t)(((r >> 8) * 2 + li) * 256 + t);
        if (lane < 40) {
            const bool isq = lane < 32; const int hd = isq ? (lane >> 2) : ((lane - 32) >> 2), pc = lane & 3;
            const bf16* s1 = p + (isq ? 0 : 512) + hd * 64 + pc * 8;
            float x1[8], x2[8]; unpack8(ua0, x1); unpack8(ua1, x2); (void)s1;
            if (!isq && !lat) { float* o = a.out + OUT_K + obase * 128 + hd * 64 + pc * 8; store8f(o, x1); store8f(o + 32, x2); }
            if (lat) rope8(x1, x2, pc < 2 ? prow : pcol, (pc & 1) * 8, 1.0f / 16.0f);
            if (isq) {
#pragma unroll
                for (int e = 0; e < 8; ++e) { x1[e] *= QS_A; x2[e] *= QS_A; }
                bf16* d = Qa + (size_t)r * 512 + hd * 64 + pc * 8; *(u32x4*)d = pack8(x1); *(u32x4*)(d + 32) = pack8(x2);
            } else { bf16* d = Ka + (size_t)r * 128 + hd * 64 + pc * 8; *(u32x4*)d = pack8(x1); *(u32x4*)(d + 32) = pack8(x2); }
        } else if (lane < 56) {
            const int c = lane - 40; const u32x4 w = ua0;
            *(u32x4*)(Va + (size_t)r * 128 + c * 8) = w;
            if (!lat) { float f[8]; unpack8(w, f); store8f(a.out + OUT_V + obase * 128 + c * 8, f); }
        } else if (lane < 58) {
            const int pc = lane - 56; float x1[8], x2[8]; unpack8(ua0, x1); unpack8(ua1, x2);
            if (!lat) { float* o = a.out + OUT_KR + obase * 32 + pc * 8; store8f(o, x1); store8f(o + 16, x2); }
            if (lat) rope8(x1, x2, pc == 0 ? prow : pcol, 0, 1.0f / 8.0f);
            bf16* d = KRR + (size_t)r * 32 + pc * 8; *(u32x4*)d = pack8(x1); *(u32x4*)(d + 16) = pack8(x2);
        }
        float v[8]; float ss = 0.f;
        const bool iscq = lane < 24, isckv = lane >= 24 && lane < 40;
        if (iscq || isckv) unpack8(un, v);
        else {
#pragma unroll
            for (int e = 0; e < 8; ++e) v[e] = 0.f; }
#pragma unroll
        for (int e = 0; e < 8; ++e) ss += v[e] * v[e];
        const float sq = wave_sum(iscq ? ss : 0.f, lane), skv = wave_sum(isckv ? ss : 0.f, lane);
        if (iscq) { const float rs = 1.0f / sqrtf(sq * (1.0f / 192.0f) + EPS);
#pragma unroll
            for (int e = 0; e < 8; ++e) v[e] = v[e] * rs * gnv[e];
            *(u32x4*)(CQN + (size_t)r * 256 + lane * 8) = pack8(v);
        } else if (isckv) { const float rs = 1.0f / sqrtf(skv * (1.0f / 128.0f) + EPS);
#pragma unroll
            for (int e = 0; e < 8; ++e) v[e] = v[e] * rs * gnv[e];
            *(u32x4*)(CKVN + (size_t)r * 128 + (lane - 24) * 8) = pack8(v);
            if (!lat) store8f(a.out + OUT_CKV + obase * 128 + (lane - 24) * 8, v);
        } else if (lane < 48) { unsigned z0 = 0u; asm volatile("" : "+v"(z0)); *(u32x4*)(CQN + (size_t)r * 256 + 192 + (lane - 40) * 8) = (u32x4){z0, z0, z0, z0}; }
        ua0 = na0; ua1 = na1; un = nn;
    }
#undef PP_LOAD
}

typedef short v4i16_t __attribute__((ext_vector_type(4)));
__device__ __forceinline__ int crow(int r, int hi) { return (r & 3) + 8 * (r >> 2) + 4 * hi; }
__device__ __forceinline__ s16x4 vtr(const LAS unsigned char* p) { return __builtin_bit_cast(s16x4, __builtin_amdgcn_ds_read_tr16_b64_v4i16((LAS v4i16_t*)p)); }
typedef float f32x2_t __attribute__((ext_vector_type(2))); typedef __bf16 bf16x2_t __attribute__((ext_vector_type(2)));
__device__ __forceinline__ unsigned cvtpk(float lo, float hi) { f32x2_t v = {lo, hi}; bf16x2_t b = __builtin_convertvector(v, bf16x2_t); return __builtin_bit_cast(unsigned, b); }

constexpr int ATT_KBUF = 0, ATT_KBYTES = 64 * 208, ATT_VBUF = 2 * ATT_KBYTES, ATT_VBYTES = 8192, ATT_WSF = ATT_VBUF + 2 * ATT_VBYTES, ATT_OST = ATT_WSF + NWAVES * 256, ATT_END = ATT_OST + NWAVES * 4096;
static_assert(ATT_END <= 131072, "attention LDS");

struct AttnUnitDesc {
    const bf16* Qw; int qpitch;
    const bf16* K1; int k1p;
    const bf16* K2; int k2p;
    const bf16* V; int vp;
    int row0a, nta, row0b, ntb;
    bf16* Ow;
    float sink_l2; int has_sink;
    int win; int qpos0; int kpos0;
};

template <int DQ>
__device__ __forceinline__ void attn_unit(LAS unsigned char* lds, const AttnUnitDesc& U, int tid, int wave, int lane) {
    constexpr int KP = DQ * 2 + 16, ND = DQ / 16;
    const int r32 = lane & 31, hi = lane >> 5;
    LAS float* wsf = (LAS float*)(lds + ATT_WSF + wave * 256);
    bf16x8 qr[ND];
#pragma unroll
    for (int d0 = 0; d0 < ND; ++d0) qr[d0] = *(const GAS bf16x8*)(U.Qw + (size_t)r32 * U.qpitch + d0 * 16 + hi * 8);
    f32x16 o[2];
#pragma unroll
    for (int i = 0; i < 16; ++i) { o[0][i] = 0.f; o[1][i] = 0.f; }
    float m = 0.f, l = 0.f;
    const int ntot = U.nta + U.ntb;
    const int skey = tid >> 3, sch = tid & 7;
    u32x4 kreg, vreg, k2reg;
#define ATT_GLOAD(j) do { const int row_ = ((j) < U.nta ? U.row0a + 64 * (j) : U.row0b + 64 * ((j) - U.nta)); \
        kreg = *(const GAS u32x4*)(U.K1 + (size_t)(row_ + skey) * U.k1p + sch * 8); \
        vreg = *(const GAS u32x4*)(U.V + (size_t)(row_ + skey) * U.vp + sch * 8); \
        if (DQ == 96) { if (tid < 256) k2reg = *(const GAS u32x4*)(U.K2 + (size_t)(row_ + (tid >> 2)) * U.k2p + (tid & 3) * 8); } } while (0)
#define ATT_LSTORE(buf) do { \
        *(LAS u32x4*)(lds + ATT_KBUF + (buf) * ATT_KBYTES + skey * KP + sch * 16) = kreg; \
        *(LAS u32x4*)(lds + ATT_VBUF + (buf) * ATT_VBYTES + (sch >> 2) * 4096 + skey * 64 + (sch & 3) * 16) = vreg; \
        if (DQ == 96) { if (tid < 256) *(LAS u32x4*)(lds + ATT_KBUF + (buf) * ATT_KBYTES + (tid >> 2) * KP + 128 + (tid & 3) * 16) = k2reg; } } while (0)
    ATT_GLOAD(0); ATT_LSTORE(0);
    __syncthreads();
    for (int j = 0; j < ntot; ++j) {
        const int buf = j & 1;
        if (j + 1 < ntot) ATT_GLOAD(j + 1);
        bool skip = false, masked = false; int kp_lo = 0;
        if (U.win && j < U.nta) { kp_lo = U.kpos0 + 64 * j;
            skip = (kp_lo + 63 < U.qpos0 - 128) || (kp_lo > U.qpos0 + 31 + 128);
            masked = !((kp_lo >= U.qpos0 + 31 - 128) && (kp_lo + 63 <= U.qpos0 + 128)); }
        if (!skip) {
            const LAS unsigned char* Kt = lds + ATT_KBUF + buf * ATT_KBYTES + r32 * KP + hi * 16;
            f32x16 p0, p1;
            { const float nm = -m;
#pragma unroll
            for (int i = 0; i < 16; ++i) { p0[i] = nm; p1[i] = nm; } }
            const LAS unsigned char* Vt = lds + ATT_VBUF + buf * ATT_VBYTES + ((lane >> 4) & 1) * 32 + (lane & 3) * 8 + (4 * hi + ((lane & 15) >> 2)) * 64;
            bf16x8 ka[3][2]; s16x4 vl[3][2];
#define ATT_KLD(d_) do { ka[(d_) % 3][0] = *(const LAS bf16x8*)(Kt + (d_) * 32); ka[(d_) % 3][1] = *(const LAS bf16x8*)(Kt + 32 * KP + (d_) * 32); } while (0)
#define ATT_VLD(i_) do { vl[(i_) % 3][0] = vtr(Vt + ((i_) & 1) * 4096 + ((i_) >> 1) * 1024); vl[(i_) % 3][1] = vtr(Vt + ((i_) & 1) * 4096 + ((i_) >> 1) * 1024 + 512); } while (0)
            ATT_KLD(0); ATT_KLD(1);
#pragma unroll
            for (int d0 = 0; d0 < ND; ++d0) {
                if (d0 + 2 < ND) ATT_KLD(d0 + 2);
                __builtin_amdgcn_sched_barrier(0);
                p0 = __builtin_amdgcn_mfma_f32_32x32x16_bf16(ka[d0 % 3][0], qr[d0], p0, 0, 0, 0);
                p1 = __builtin_amdgcn_mfma_f32_32x32x16_bf16(ka[d0 % 3][1], qr[d0], p1, 0, 0, 0);
                __builtin_amdgcn_sched_barrier(0);
            }
            ATT_VLD(0); ATT_VLD(1);
            __builtin_amdgcn_sched_barrier(0);
            if (masked) { const int qp = U.qpos0 + r32;
#pragma unroll
                for (int i = 0; i < 16; ++i) { const int kp = kp_lo + crow(i, hi); const int d0_ = qp - kp, d1_ = qp - (kp + 32);
                    if (d0_ > 128 || d0_ < -128) p0[i] = NEGBIG; if (d1_ > 128 || d1_ < -128) p1[i] = NEGBIG; } }
            float mt = __builtin_fmaxf(p0[0], p1[0]);
#pragma unroll
            for (int i = 1; i < 16; ++i) mt = __builtin_fmaxf(__builtin_fmaxf(mt, p0[i]), p1[i]);
            mt = __builtin_fmaxf(mt, shfl_xor_l(mt, lane, 32));
            if (__any(mt > 4.0f)) {
                const float dl = __builtin_fmaxf(mt, 0.f); m += dl;
                const float alpha = __builtin_amdgcn_exp2f(-dl); l *= alpha;
#pragma unroll
                for (int i = 0; i < 16; ++i) { p0[i] -= dl; p1[i] -= dl; }
                if (hi == 0) wsf[r32] = alpha;
                asm volatile("s_waitcnt lgkmcnt(0)" ::: "memory");
#pragma unroll
                for (int i = 0; i < 16; ++i) { const float f = wsf[crow(i, hi)]; o[0][i] *= f; o[1][i] *= f; }
            }
            float ls = 0.f;
#pragma unroll
            for (int i = 0; i < 16; ++i) { p0[i] = __builtin_amdgcn_exp2f(p0[i]); p1[i] = __builtin_amdgcn_exp2f(p1[i]); ls += p0[i] + p1[i]; }
            l += ls;
            u32x4 pw[4];
#pragma unroll
            for (int s = 0; s < 2; ++s) {
                pw[s] = (u32x4){cvtpk(p0[8 * s], p0[8 * s + 1]), cvtpk(p0[8 * s + 2], p0[8 * s + 3]), cvtpk(p0[8 * s + 4], p0[8 * s + 5]), cvtpk(p0[8 * s + 6], p0[8 * s + 7])};
                pw[2 + s] = (u32x4){cvtpk(p1[8 * s], p1[8 * s + 1]), cvtpk(p1[8 * s + 2], p1[8 * s + 3]), cvtpk(p1[8 * s + 4], p1[8 * s + 5]), cvtpk(p1[8 * s + 6], p1[8 * s + 7])};
            }
            __builtin_amdgcn_sched_barrier(0);
#pragma unroll
            for (int i = 0; i < 8; ++i) {
                if (i + 2 < 8) ATT_VLD(i + 2);
                __builtin_amdgcn_sched_barrier(0);
                const s16x4 lo = vl[i % 3][0], hh = vl[i % 3][1];
                const bf16x8 vf = (bf16x8){lo[0], lo[1], lo[2], lo[3], hh[0], hh[1], hh[2], hh[3]};
                o[i & 1] = __builtin_amdgcn_mfma_f32_32x32x16_bf16(__builtin_bit_cast(bf16x8, pw[i >> 1]), vf, o[i & 1], 0, 0, 0);
                __builtin_amdgcn_sched_barrier(0);
            }
#undef ATT_KLD
#undef ATT_VLD
        }
        if (j + 1 < ntot) ATT_LSTORE(buf ^ 1);
        __syncthreads();
    }
    l += shfl_xor_l(l, lane, 32);
    if (U.has_sink) l += __builtin_amdgcn_exp2f(U.sink_l2 - m);
    if (hi == 0) wsf[32 + r32] = 1.0f / l;
    asm volatile("s_waitcnt lgkmcnt(0)" ::: "memory");
    LAS bf16* stg = (LAS bf16*)(lds + ATT_OST + wave * 4096);
#pragma unroll
    for (int i = 0; i < 16; ++i) { const int orow = crow(i, hi); const float rl = wsf[32 + orow];
        stg[orow * 64 + r32] = (bf16)f2bf(o[0][i] * rl); stg[orow * 64 + 32 + r32] = (bf16)f2bf(o[1][i] * rl); }
    asm volatile("s_waitcnt lgkmcnt(0)" ::: "memory");
#pragma unroll
    for (int i = 0; i < 4; ++i) { const int row = i * 8 + (lane >> 3), ch = lane & 7; const u32x4 v = *(const LAS u32x4*)(stg + row * 64 + ch * 8);
        *(GAS u32x4*)(U.Ow + (size_t)row * 1024 + ch * 8) = v; }
    asm volatile("s_waitcnt lgkmcnt(0)" ::: "memory");
}

__device__ __forceinline__ void attn_phase(const Args& a, int li, LAS unsigned char* lds, int bid, int G, int tid, int wave, int lane) {
    unsigned char* ws = a.ws;
    const bf16* Qa = (const bf16*)(ws + WS_QA); const bf16* Ka = (const bf16*)(ws + WS_KA); const bf16* Va = (const bf16*)(ws + WS_VA);
    const bf16* KRR = (const bf16*)(ws + WS_KRR); const bf16* Qm = (const bf16*)(ws + WS_QM); const bf16* KV = (const bf16*)(ws + WS_KV);
    bf16* O = (bf16*)(ws + WS_O);
    constexpr int NU0 = 512, NU1 = 512, NU2 = 128, NU3 = 128, NU = NU0 + NU1 + NU2 + NU3;
    const int cl = (G % 8 == 0) ? (bid % 8) * (G / 8) + bid / 8 : bid;
    for (int u = cl; u < NU; u += G) {
        AttnUnitDesc D;
        if (u < NU0) {
            const int qb = u & 7, h = (u >> 3) & 7, b = u >> 6; const int row = NCTX + b * 2048 + qb * 256 + wave * 32;
            D.Qw = Qm + (size_t)row * 768 + h * 96; D.qpitch = 768; D.K1 = KV + h * 128; D.k1p = 1024; D.K2 = KRR; D.k2p = 32; D.V = KV + h * 128 + 64; D.vp = 1024;
            D.row0a = NCTX + b * 2048; D.nta = 32; D.row0b = T + b * 256; D.ntb = 4; D.Ow = O + (size_t)row * 1024 + 512 + h * 64;
            D.sink_l2 = 0.f; D.has_sink = 0; D.win = 0; D.qpos0 = 0; D.kpos0 = 0;
            attn_unit<96>(lds, D, tid, wave, lane);
        } else if (u < NU0 + NU1) {
            const int v = u - NU0; const int pair = v & 1, nb = (v >> 1) & 15, kvh = (v >> 5) & 1, b = v >> 6;
            const int head = kvh * 4 + pair * 2 + (wave >> 2), qoff = (wave & 3) * 32; const int row = NCTX + b * 2048 + nb * 128 + qoff;
            const int kb_lo = nb > 0 ? nb - 1 : 0, kb_hi = nb + 2 < 16 ? nb + 2 : 16;
            D.Qw = Qa + (size_t)row * 512 + head * 64; D.qpitch = 512; D.K1 = Ka + kvh * 64; D.k1p = 128; D.K2 = nullptr; D.k2p = 0; D.V = Va + kvh * 64; D.vp = 128;
            D.row0a = NCTX + b * 2048 + kb_lo * 128; D.nta = (kb_hi - kb_lo) * 2; D.row0b = T + b * 256; D.ntb = 4; D.Ow = O + (size_t)row * 1024 + head * 64;
            D.sink_l2 = a.attn_sink[li * 8 + head] * LOG2E; D.has_sink = 1; D.win = 1; D.qpos0 = nb * 128 + qoff; D.kpos0 = kb_lo * 128;
            attn_unit<64>(lds, D, tid, wave, lane);
        } else if (u < NU0 + NU1 + NU2) {
            const int v = u - NU0 - NU1; const int h = v & 7, b = v >> 3; const int row = b * 256 + wave * 32;
            D.Qw = Qm + (size_t)row * 768 + h * 96; D.qpitch = 768; D.K1 = KV + h * 128; D.k1p = 1024; D.K2 = KRR; D.k2p = 32; D.V = KV + h * 128 + 64; D.vp = 1024;
            D.row0a = b * 256; D.nta = 4; D.row0b = 0; D.ntb = 0; D.Ow = O + (size_t)row * 1024 + 512 + h * 64;
            D.sink_l2 = 0.f; D.has_sink = 0; D.win = 0; D.qpos0 = 0; D.kpos0 = 0;
            attn_unit<96>(lds, D, tid, wave, lane);
        } else {
            const int v = u - NU0 - NU1 - NU2; const int head = v & 7, b = v >> 3, kvh = head >> 2; const int row = b * 256 + wave * 32;
            D.Qw = Qa + (size_t)row * 512 + head * 64; D.qpitch = 512; D.K1 = Ka + kvh * 64; D.k1p = 128; D.K2 = nullptr; D.k2p = 0; D.V = Va + kvh * 64; D.vp = 128;
            D.row0a = b * 256; D.nta = 4; D.row0b = 0; D.ntb = 0; D.Ow = O + (size_t)row * 1024 + head * 64;
            D.sink_l2 = a.attn_sink[li * 8 + head] * LOG2E; D.has_sink = 1; D.win = 0; D.qpos0 = 0; D.kpos0 = 0;
            attn_unit<64>(lds, D, tid, wave, lane);
        }
    }
}

constexpr int CV_U = 0, CV_UROWS = 46, CV_Z = CV_UROWS * 1024, CV_ZROWS = 31, CV_CV = CV_Z + CV_ZROWS * 1024, CV_END = CV_CV + 16 * 512 * 4;
static_assert(CV_END <= 131072, "conv LDS");
template <int W>
__device__ __forceinline__ void pool_lds(const LAS unsigned char* zl, int t0, int n, int c, float (&y)[16]) {
    constexpr int LO = W / 2, HI = W - LO - 1, NV = 16 + W - 1;
    float z[NV];
#pragma unroll
    for (int i = 0; i < NV; ++i) z[i] = bf2f(*(const LAS unsigned short*)(zl + (8 - LO + i) * 1024 + c * 2));
#pragma unroll
    for (int t = 0; t < 16; ++t) { const int tt = t0 + t;
        float s = 0.f;
#pragma unroll
        for (int i = 0; i < W; ++i) s += z[t + i];
        const int st = tt - LO < 0 ? 0 : tt - LO, en = tt + HI + 1 > n ? n : tt + HI + 1;
        y[t] = s / (float)(en - st) - z[t + LO]; }
}
__device__ __forceinline__ void convpool_phase(const Args& a, int lj, LAS unsigned char* lds, int bid, int G, int tid, int wave, int lane) {
    const bf16* Ub = (const bf16*)(a.ws + WS_PROJ); const bf16* ZW = Ub + (size_t)T * 512; bf16* CAT = (bf16*)(a.ws + WS_O);
    LAS float* cv = (LAS float*)(lds + CV_CV);
    const int c = tid;
    float w[31];
#pragma unroll
    for (int j = 0; j < 31; ++j) w[j] = a.conv_dw[(size_t)(lj * 31 + j) * 512 + c];
    const float bias = a.conv_dw_b[lj * 512 + c];
    float lng[8], lnb[8];
#pragma unroll
    for (int e = 0; e < 8; ++e) { lng[e] = a.conv_ln_g[lj * 512 + 8 * lane + e]; lnb[e] = a.conv_ln_b[lj * 512 + 8 * lane + e]; }
    u32x4 ur[6], zr[4];
#define CV_DECODE(u_, rs_, t0_, n_) do { if ((u_) < 256) { rs_ = (size_t)((u_) >> 4) * 256; t0_ = ((u_) & 15) * 16; n_ = 256; } \
        else { const int v_ = (u_) - 256; rs_ = (size_t)NCTX + (size_t)(v_ >> 7) * 2048; t0_ = (v_ & 127) * 16; n_ = 2048; } } while (0)
#define CV_GLOAD(u_) do { size_t rs_; int t0_, n_; CV_DECODE(u_, rs_, t0_, n_); \
        _Pragma("unroll") for (int k = 0; k < 6; ++k) { const int q = tid + 512 * k; const int tt = t0_ - 15 + (q >> 6); \
            ur[k] = (q < CV_UROWS * 64 && tt >= 0 && tt < n_) ? *(const GAS u32x4*)(Ub + (rs_ + tt) * 512 + (q & 63) * 8) : (u32x4){0u, 0u, 0u, 0u}; } \
        _Pragma("unroll") for (int k = 0; k < 4; ++k) { const int q = tid + 512 * k; const int tt = t0_ - 8 + (q >> 6); \
            zr[k] = (q < CV_ZROWS * 64 && tt >= 0 && tt < n_) ? *(const GAS u32x4*)(ZW + (rs_ + tt) * 512 + (q & 63) * 8) : (u32x4){0u, 0u, 0u, 0u}; } } while (0)
    if (bid < 1280) CV_GLOAD(bid);
    for (int u = bid; u < 1280; u += G) {
        size_t rowseq0; int t0, n; CV_DECODE(u, rowseq0, t0, n);
#pragma unroll
        for (int k = 0; k < 6; ++k) { const int q = tid + 512 * k; if (q < CV_UROWS * 64) *(LAS u32x4*)(lds + CV_U + q * 16) = ur[k]; }
#pragma unroll
        for (int k = 0; k < 4; ++k) { const int q = tid + 512 * k; if (q < CV_ZROWS * 64) *(LAS u32x4*)(lds + CV_Z + q * 16) = zr[k]; }
        __syncthreads();
        if (u + G < 1280) CV_GLOAD(u + G);
        float acc[16];
#pragma unroll
        for (int t = 0; t < 16; ++t) acc[t] = bias;
#pragma unroll
        for (int r = 0; r < 46; ++r) { const float v = bf2f(*(const LAS unsigned short*)(lds + CV_U + r * 1024 + c * 2));
#pragma unroll
            for (int t = 0; t < 16; ++t) { if (r - t >= 0 && r - t <= 30) acc[t] += w[r - t] * v; } }
#pragma unroll
        for (int t = 0; t < 16; ++t) cv[t * 512 + c] = acc[t];
        float y[16];
        { const int gi = wave >> 1; const LAS unsigned char* zl = lds + CV_Z;
          if (gi == 0) pool_lds<2>(zl, t0, n, c, y); else if (gi == 1) pool_lds<4>(zl, t0, n, c, y); else if (gi == 2) pool_lds<8>(zl, t0, n, c, y); else pool_lds<16>(zl, t0, n, c, y); }
        __syncthreads();
        LAS unsigned char* ost = lds + CV_U;
#pragma unroll
        for (int q = 0; q < 2; ++q) { const int t = 2 * wave + q;
            const f32x4 v0 = *(const LAS f32x4*)(cv + t * 512 + 8 * lane), v1 = *(const LAS f32x4*)(cv + t * 512 + 8 * lane + 4);
            float x[8] = {v0.x, v0.y, v0.z, v0.w, v1.x, v1.y, v1.z, v1.w};
            float s = 0.f;
#pragma unroll
            for (int e = 0; e < 8; ++e) s += x[e];
            const float mu = wave_sum(s, lane) * (1.0f / 512.0f); float qq = 0.f;
#pragma unroll
            for (int e = 0; e < 8; ++e) { x[e] -= mu; qq += x[e] * x[e]; }
            const float rstd = 1.0f / sqrtf(wave_sum(qq, lane) * (1.0f / 512.0f) + EPS);
#pragma unroll
            for (int e = 0; e < 8; ++e) { const float yy = x[e] * rstd * lng[e] + lnb[e]; x[e] = yy * __builtin_amdgcn_rcpf(1.0f + __expf(-yy)); }
            *(LAS u32x4*)(ost + t * 2048 + lane * 16) = pack8(x); }
#pragma unroll
        for (int t = 0; t < 16; ++t) *(LAS unsigned short*)(ost + t * 2048 + 1024 + c * 2) = (unsigned short)f2bf(y[t]);
        __syncthreads();
#pragma unroll
        for (int k = 0; k < 4; ++k) { const int q = tid + 512 * k; const int row = q >> 7, ch = q & 127;
            *(GAS u32x4*)(CAT + (rowseq0 + t0 + row) * 1024 + ch * 8) = *(const LAS u32x4*)(ost + row * 2048 + ch * 16); }
        __syncthreads();
    }
#undef CV_DECODE
#undef CV_GLOAD
}

#define XB_TMO      128
#define XB_XCNT(j)  (256  + 64 * (j))
#define XB_XSUB(j)  (1280 + 64 * (j))
#define XB_XGEN(j)  (2304 + 64 * (j))
#define XB_TOP      3328
#define XB_TOPGEN   3392
#define XCD_BAR_WORDS 3456
#define XB_SPIN_CAP (1u << 18)

__device__ __forceinline__ unsigned xb_ld(unsigned* p)              { return __hip_atomic_load(p, __ATOMIC_RELAXED, __HIP_MEMORY_SCOPE_AGENT); }
__device__ __forceinline__ unsigned xb_add(unsigned* p, unsigned v) { return __hip_atomic_fetch_add(p, v, __ATOMIC_RELAXED, __HIP_MEMORY_SCOPE_AGENT); }
__device__ __forceinline__ unsigned xb_xcc_id() { return (unsigned)__builtin_amdgcn_s_getreg((3 << 11) | 20) & 0xFu; }
#define XB_SPIN(cond, bar) do { unsigned _sp = 0; while (cond) { __builtin_amdgcn_s_sleep(1); \
    if ((++_sp & 255u) == 0u) { if (xb_ld(&(bar)[XB_TMO])) break; if (_sp > XB_SPIN_CAP) { atomicAdd(&(bar)[XB_TMO], 1u); break; } } } } while (0)

struct XcdBarrier {
    unsigned* bar; unsigned x;
    volatile LAS unsigned* st;
};

__device__ __forceinline__ XcdBarrier xcd_barrier_post(unsigned* bar, volatile LAS unsigned* st) {
    XcdBarrier b; b.bar = bar; b.x = xb_xcc_id(); b.st = st;
    if (threadIdx.x == 0) (void)xb_add(&bar[XB_XCNT(b.x)], 1u);
    return b;
}
__device__ __forceinline__ void xcd_barrier_complete(unsigned* bar, unsigned x, unsigned& nloc, unsigned& nx) {
    const unsigned G = gridDim.x * gridDim.y * gridDim.z;
    unsigned sum, cnt, mine, sp = 0u;
    for (;;) {
        sum = 0u; cnt = 0u; mine = 0u;
#pragma unroll
        for (unsigned j = 0; j < 16; ++j) { const unsigned c = xb_ld(&bar[XB_XCNT(j)]); sum += c; cnt += (c > 0u) ? 1u : 0u; mine = (j == x) ? c : mine; }
        if (sum == G) break;
        __builtin_amdgcn_s_sleep(1);
        if ((++sp & 255u) == 0u) { if (xb_ld(&bar[XB_TMO])) break; if (sp > XB_SPIN_CAP) { atomicAdd(&bar[XB_TMO], 1u); break; } }
    }
    nloc = mine > 0u ? mine : 1u; nx = cnt > 0u ? cnt : 1u;
}

__device__ __forceinline__ void xcd_barrier(const XcdBarrier& b) {
    asm volatile("s_waitcnt vmcnt(0)" ::: "memory");
    __syncthreads();
    if (threadIdx.x == 0) {
        unsigned* bar = b.bar;
        __builtin_amdgcn_s_waitcnt(0);
        unsigned nloc = b.st[0], nx = b.st[1];
        if (nloc == 0u) { xcd_barrier_complete(bar, b.x, nloc, nx); b.st[0] = nloc; b.st[1] = nx; }
        const unsigned old = xb_add(&bar[XB_XSUB(b.x)], 1u);
        const unsigned gen = old / nloc;
        if (old + 1u == (gen + 1u) * nloc) {
            __builtin_amdgcn_fence(__ATOMIC_RELEASE, "agent");
            asm volatile("s_waitcnt vmcnt(0)" ::: "memory");
            const unsigned og = xb_add(&bar[XB_TOP], 1u);
            const unsigned tg = og / nx;
            if (og + 1u == (tg + 1u) * nx) xb_add(&bar[XB_TOPGEN], 1u);
            else XB_SPIN(xb_ld(&bar[XB_TOPGEN]) == tg, bar);
            __builtin_amdgcn_fence(__ATOMIC_ACQUIRE, "agent");
            xb_add(&bar[XB_XGEN(b.x)], 1u);
            asm volatile("s_waitcnt vmcnt(0)" ::: "memory");
        } else {
            XB_SPIN(xb_ld(&bar[XB_XGEN(b.x)]) == gen, bar);
            __builtin_amdgcn_fence(__ATOMIC_ACQUIRE, "agent");
            asm volatile("s_waitcnt vmcnt(0)" ::: "memory");
        }
    }
    __syncthreads();
}

#ifndef REP_ATTN
#define REP_ATTN 1
#endif
#ifndef REP_SYNC
#define REP_SYNC 0
#endif
#ifndef REP_UP
#define REP_UP 1
#endif
#ifndef REP_NORM
#define REP_NORM 1
#endif
#ifndef REP_P0
#define REP_P0 1
#endif
#ifndef REP_CONV
#define REP_CONV 1
#endif
#ifndef REP_POST
#define REP_POST 1
#endif
#ifndef REP_DOWN
#define REP_DOWN 1
#endif
#ifndef KVB_AL
#define KVB_AL false
#endif
#ifndef KVB_SP
#define KVB_SP true
#endif
#ifndef REP_G1
#define REP_G1 1
#endif
template <class T_> struct unparen_; template <class T_> struct unparen_<void(T_)> { typedef T_ type; };
#define UNPAREN(...) typename unparen_<void(__VA_ARGS__)>::type
#define GEMM_PHASE(EpiT, Aptr, Bptr, M_, N_, K_, ...) GEMM_PHASE_F(true, true, EpiT, Aptr, Bptr, M_, N_, K_, __VA_ARGS__)
#define GEMM_PHASE_F(AL_, SP_, EpiT, Aptr, Bptr, M_, N_, K_, ...) do { typedef unparen_<void(EpiT)>::type Epi_; int kk_ = (K_); pg8::Gemm g_{(const pg8::bf16_t*)(Aptr), (const pg8::bf16_t*)(Bptr), (M_), (N_), kk_}; pg8::StaticOrder S_; S_.init((M_), (N_), (K_), G, bid); \
    Epi_ E_{__VA_ARGS__}; pg8::gemm_phase<Epi_, pg8::StaticOrder, AL_, SP_>(lds, g_, S_, E_, tid); } while (0)

#define GEMM_PHASE_RESID(Aptr, Bptr, K_, l_, gi, sn) GEMM_PHASE_RESID2(pg8::RoundSplitOrder, Aptr, Bptr, K_, l_, gi, sn, 1.0f, (float*)(ws + WS_ROWSQ) + (size_t)((sn) & 7) * T)
#define GEMM_PHASE_RESID_STATIC(Aptr, Bptr, K_, l_, gi, sn) GEMM_PHASE_RESID2(pg8::StaticOrder4, Aptr, Bptr, K_, l_, gi, sn, 1.0f, (float*)(ws + WS_ROWSQ) + (size_t)((sn) & 7) * T)
#define GEMM_PHASE_RESID2(Ord_, Aptr, Bptr, K_, l_, gi, sn, gs_, rsqp_) do { pg8::Gemm g_{(const pg8::bf16_t*)(Aptr), (const pg8::bf16_t*)(Bptr), T, DM, (K_)}; Ord_ S_; S_.init(T, DM, (K_), 4, G, bid); \
    const float* mod_ = (const float*)(ws + WS_MOD); const int sn_ = (sn); \
    pg8::EpiResid E_{(float*)(ws + WS_X), mod_ + (size_t)(l_) * 9 * 6144 + (gi) * 1024, sn_ < 8 ? (pg8::bf16_t*)(ws + WS_H) : (pg8::bf16_t*)nullptr, pa.norm_g + (size_t)(sn_ & 7) * DM, \
        mod_ + (size_t)((sn_ & 7) >> 1) * 9 * 6144 + ((sn_ & 1) ? 4 : 1) * 1024, (rsqp_), (gs_), pa.out, (unsigned*)(ws + 16384), 4u * (unsigned)(nsplit += Ord_::kSplit), (K_) / 64}; \
    pg8::gemm_phase<pg8::EpiResid, Ord_, true, true>(lds, g_, S_, E_, tid); } while (0)

__global__ void __launch_bounds__(NTHREADS, 2) trunk_fwd(Args a) {
    extern __shared__ __attribute__((aligned(16))) unsigned char lds_raw[];
    LAS unsigned char* lds = (LAS unsigned char*)lds_raw;
    cg::grid_group grid = cg::this_grid();
    const int tid0 = threadIdx.x, bid0 = blockIdx.x, G = gridDim.x, NGW = G * NWAVES;
    const int wave0 = __builtin_amdgcn_readfirstlane(tid0 >> 6);
    int ph = 0; int nsplit = 0;
    unsigned* barw = (unsigned*)a.ws;
    if (a.ph_hi < 0) grid.sync();
    volatile LAS unsigned* MISC = (volatile LAS unsigned*)(lds + 131072 + 320);
    if (tid0 < 32) MISC[tid0] = 0u;
    __syncthreads();
    XcdBarrier xbar = xcd_barrier_post(barw, MISC + 8);
#define PHASE_BEGIN if (ph >= a.ph_lo && ph < a.ph_hi) { unsigned ones_ = ~0u; asm volatile("" : "+s"(ones_)); int tid = wave0 * 64 + (int)__builtin_amdgcn_mbcnt_hi(ones_, __builtin_amdgcn_mbcnt_lo(ones_, 0u)); int bid = bid0; asm volatile("" : "+s"(bid)); unsigned char* ws = a.ws; asm volatile("" : "+s"(ws)); Args pa = a; pa.ws = ws; \
    const int lane = tid & 63, wave = __builtin_amdgcn_readfirstlane(tid >> 6), gw = bid * NWAVES + wave; (void)lane; (void)gw; (void)ws;
#define PHASE_END(dosync_) if ((dosync_) && ph + 1 < a.ph_hi) { xcd_barrier(xbar); } } ++ph;

    PHASE_BEGIN
        for (int rep_ = 0; rep_ < REP_P0; ++rep_) {
        p0_adaln(pa, lds, bid, G, tid);
        __syncthreads();
        p0_fold(pa, lds, bid, G, tid);
        __syncthreads();
        p0_transposes(pa, lds, gw, NGW, wave, lane);
        __syncthreads(); }
    PHASE_END(true)

    PHASE_BEGIN
        prep_pass(pa, gw, NGW, lane);
    PHASE_END(true)

    for (int l = 0; l < DEPTH; ++l) {
        const float* rsq0 = (const float*)(a.ws + WS_ROWSQ) + (size_t)(2 * l) * T; const float* bias0 = (const float*)(a.ws + WS_BIAS) + (size_t)(2 * l) * 9 * 4096;
        if ((l & 1) == 0) {
            const int li = l >> 1;
            PHASE_BEGIN
                GEMM_PHASE((pg8::EpiStore<0, true>), ws + WS_H, (bf16*)(ws + WS_WIN) + (size_t)li * AINP * DM, T, AINP, DM, (pg8::bf16_t*)(ws + WS_PROJ), AINP, rsq0, bias0);
            PHASE_END(true)
            PHASE_BEGIN
                post_pass(pa, li, gw, NGW, lane);
            PHASE_END(true)
            PHASE_BEGIN
                GEMM_PHASE((pg8::EpiQm), ws + WS_CQN, (bf16*)(ws + WS_WQB) + (size_t)li * 768 * 256, T, 768, 256, (pg8::bf16_t*)(ws + WS_QM), QS_M);
                GEMM_PHASE_F(KVB_AL, KVB_SP, (pg8::EpiStore<0, false>), ws + WS_CKVN, (bf16*)(ws + WS_WKVB) + (size_t)li * 1024 * 128, TR, 1024, 128, (pg8::bf16_t*)(ws + WS_KV), 1024, (const float*)nullptr, (const float*)nullptr);
            PHASE_END(true)
            PHASE_BEGIN
                for (int rep_ = 0; rep_ < REP_ATTN; ++rep_) { attn_phase(pa, li, lds, bid, G, tid, wave, lane); if (rep_ + 1 < REP_ATTN) xcd_barrier(xbar); }
            PHASE_END(true)
            PHASE_BEGIN
                GEMM_PHASE_RESID(ws + WS_O, (bf16*)(ws + WS_WOUT) + (size_t)li * DM * DM, DM, l, 2, 2 * l + 1);
            PHASE_END(true)
        } else {
            const int lj = l >> 1;
            PHASE_BEGIN
                GEMM_PHASE((pg8::EpiGlu), ws + WS_H, (bf16*)(ws + WS_CIN) + (size_t)lj * 1536 * DM, T, 1536, DM, (pg8::bf16_t*)(ws + WS_PROJ), (pg8::bf16_t*)(ws + WS_PROJ) + (size_t)T * 512, rsq0, bias0);
            PHASE_END(true)
            PHASE_BEGIN
                for (int rep_ = 0; rep_ < REP_CONV; ++rep_) { convpool_phase(pa, lj, lds, bid, G, tid, wave, lane); if (rep_ + 1 < REP_CONV) xcd_barrier(xbar); }
            PHASE_END(true)
            PHASE_BEGIN
                GEMM_PHASE_RESID(ws + WS_O, (bf16*)(ws + WS_COUT) + (size_t)lj * DM * DM, DM, l, 2, 2 * l + 1);
            PHASE_END(true)
        }
        PHASE_BEGIN
            for (int rep_ = 0; rep_ < REP_UP; ++rep_) {
            GEMM_PHASE((pg8::EpiStore<1, true>), ws + WS_H, (bf16*)(ws + WS_W1) + (size_t)l * FF * DM, T, FF, DM, (pg8::bf16_t*)(ws + WS_HID), FF, rsq0 + T, bias0 + 9 * 4096);
            }
        PHASE_END(true)
        PHASE_BEGIN
            GEMM_PHASE_RESID(ws + WS_HID, (bf16*)(ws + WS_W2) + (size_t)l * DM * FF, FF, l, 5, 2 * l + 2);
#if REP_DOWN > 1
            GEMM_PHASE_RESID2(pg8::RoundSplitOrder, ws + WS_HID, (bf16*)(ws + WS_W2) + (size_t)l * DM * FF, FF, l, 5, 2 * l + 2, 0.0f, (float*)(ws + 768 * 1024));
#endif
        PHASE_END(true)
    }
    PHASE_BEGIN
        for (int rep_ = 0; rep_ < REP_SYNC; ++rep_) xcd_barrier(xbar);
        final_norm(pa, (const float*)nullptr, gw, NGW, lane);
    PHASE_END(false)
}

extern "C" void kernel_launch(void* const* d_in, const int* in_sizes, int n_in, void* d_out, int out_size, void* d_ws, size_t ws_size, hipStream_t stream) {
    static int grid = 0;
    if (grid == 0) {
        if (n_in != 29 || (size_t)out_size != OUT_END || ws_size < WS_END) { fprintf(stderr, "kernel_launch: unexpected sizes n_in %d out %d ws %zu (need %zu)\n", n_in, out_size, ws_size, (size_t)WS_END); grid = -1; return; }
        int dev = 0, cus = 0, per_cu = 0;
        (void)hipGetDevice(&dev); (void)hipDeviceGetAttribute(&cus, hipDeviceAttributeMultiprocessorCount, dev);
        if (hipFuncSetAttribute((const void*)trunk_fwd, hipFuncAttributeMaxDynamicSharedMemorySize, LDS_BYTES) != hipSuccess) { fprintf(stderr, "kernel_launch: hipFuncSetAttribute failed\n"); grid = -1; return; }
        if (hipOccupancyMaxActiveBlocksPerMultiprocessor(&per_cu, (const void*)trunk_fwd, NTHREADS, LDS_BYTES) != hipSuccess || per_cu < 1) { fprintf(stderr, "kernel_launch: occupancy query says %d\n", per_cu); (void)hipGetLastError(); per_cu = 1; }
        if (cus < 256) { fprintf(stderr, "kernel_launch: needs 256 CUs (split-K deal), got %d\n", cus); grid = -1; return; }
        grid = 256;
    }
    if (grid < 0) return;
    if (hipMemsetAsync(d_ws, 0, 32768, stream) != hipSuccess) { fprintf(stderr, "kernel_launch: hipMemsetAsync failed\n"); return; }
    Args a{};
    const float** pp = (const float**)&a;
    for (int i = 0; i < 29; ++i) pp[i] = (const float*)d_in[i];
    a.out = (float*)d_out; a.ws = (unsigned char*)d_ws; a.ph_lo = 0; a.ph_hi = 1000;
    void* args[] = {&a};
    hipError_t e = hipLaunchCooperativeKernel((const void*)trunk_fwd, dim3(grid), dim3(NTHREADS), args, LDS_BYTES, stream);
    if (e != hipSuccess) fprintf(stderr, "cooperative launch failed: %s (grid %d)\n", hipGetErrorString(e), grid);
}
```
